# Optimizing an MI355X kernel written in HIP

```python
import jax, jax.numpy as jnp
from jax import lax
import numpy as np

D_MODEL = 2048
BATCH = 4
SEQ = 4096
DEPTH = 1

CHUNK = 64
Q_BLOCK = 128
RET_HEADS = D_MODEL // 256
RET_DK = 128
RET_DV = 128
RET_QK = RET_HEADS * RET_DK
RET_WIDTH = RET_HEADS * RET_DV
MLA_HEADS = D_MODEL // 256
MLA_NOPE = 128
MLA_ROPE = 64
MLA_DV = 128
MLA_Q_RANK = 768
MLA_KV_RANK = 512
MLA_WIDTH = MLA_HEADS * MLA_DV
MIX_WIDTH = RET_WIDTH + MLA_WIDTH
IN_SIZES = (RET_QK, RET_QK, RET_WIDTH, RET_WIDTH, MLA_Q_RANK, MLA_KV_RANK, MLA_ROPE)
IN_WIDTH = RET_QK * 2 + RET_WIDTH * 2 + MLA_Q_RANK + MLA_KV_RANK + MLA_ROPE
D_FF = 4 * D_MODEL
ROPE_BASE = 10000.0
EPS = 1e-5
DEEPNORM_ALPHA = (2.0 * DEPTH) ** 0.25
DEEPNORM_BETA = (8.0 * DEPTH) ** -0.25

kernel_name = 'hymba_retention_mla_deepnorm_block'


def _layer_norm(x, g, b):
    xf = x.astype(jnp.float32)
    mu = jnp.mean(xf, axis=-1, keepdims=True)
    var = jnp.mean(jnp.square(xf - mu), axis=-1, keepdims=True)
    return ((xf - mu) * lax.rsqrt(var + EPS) * g + b).astype(x.dtype)


def _rms_norm(x, g):
    xf = x.astype(jnp.float32)
    return (xf * lax.rsqrt(jnp.mean(jnp.square(xf), axis=-1, keepdims=True) + EPS) * g).astype(x.dtype)


def _rope(x, positions):
    d = x.shape[-1]
    inv = ROPE_BASE ** (-jnp.arange(0, d, 2, dtype=jnp.float32) / d)
    ang = positions.astype(jnp.float32)[..., None] * inv
    ang = ang.reshape(ang.shape[:2] + (1,) * (x.ndim - 3) + ang.shape[-1:])
    cos, sin = jnp.cos(ang), jnp.sin(ang)
    xf = x.astype(jnp.float32)
    x1, x2 = xf[..., : d // 2], xf[..., d // 2:]
    return jnp.concatenate([x1 * cos - x2 * sin, x1 * sin + x2 * cos], axis=-1).astype(x.dtype)


def _retention(q, k, v):
    B, S, H, dk = q.shape
    dv = v.shape[-1]
    nc = S // CHUNK
    dt = q.dtype
    q = q.reshape(B, nc, CHUNK, H, dk).transpose(0, 3, 1, 2, 4)
    k = k.reshape(B, nc, CHUNK, H, dk).transpose(0, 3, 1, 2, 4) * (dk ** -0.5)
    v = v.reshape(B, nc, CHUNK, H, dv).transpose(0, 3, 1, 2, 4)
    log_g = jnp.log1p(-jnp.exp2(-5.0 - jnp.arange(H, dtype=jnp.float32)))
    idx = jnp.arange(CHUNK, dtype=jnp.float32)
    intra_decay = jnp.exp(log_g[:, None, None] * jnp.abs(idx[:, None] - idx[None, :])).astype(dt)
    k_decay = jnp.exp(log_g[:, None] * (CHUNK - 1 - idx)).astype(dt)
    q_decay = jnp.exp(log_g[:, None] * (idx + 1.0)).astype(dt)
    chunk_decay = jnp.exp(log_g * CHUNK).astype(dt)[:, None, None]
    scores = jnp.einsum('bhnid,bhnjd->bhnij', q, k) * intra_decay[:, None]
    intra = jnp.einsum('bhnij,bhnje->bhnie', scores, v)
    kv = jnp.einsum('bhnjd,bhnje->nbhde', k * k_decay[:, None, :, None], v)

    def step(state, kv_c):
        return chunk_decay * state + kv_c, state

    _, s_prev = lax.scan(step, jnp.zeros((B, H, dk, dv), kv.dtype), kv)
    cross = jnp.einsum('bhnid,nbhde->bhnie', q * q_decay[:, None, :, None], s_prev)
    return (intra + cross).transpose(0, 2, 3, 1, 4).reshape(B, S, H, dv)


def _mla(c_q, c_kv, k_r, positions, q_norm_g, w_uq, kv_norm_g, w_uk, w_uv):
    B, S, _ = c_q.shape
    H = MLA_HEADS
    q = (_rms_norm(c_q, q_norm_g) @ w_uq).reshape(B, S, H, MLA_NOPE + MLA_ROPE)
    q_nope = q[..., :MLA_NOPE]
    q_rope = _rope(q[..., MLA_NOPE:], positions)
    ckv = _rms_norm(c_kv, kv_norm_g)
    k_nope = (ckv @ w_uk).reshape(B, S, H, MLA_NOPE)
    v = (ckv @ w_uv).reshape(B, S, H, MLA_DV)
    k_rope = _rope(k_r, positions)
    scale = (MLA_NOPE + MLA_ROPE) ** -0.5
    nqb = S // Q_BLOCK
    qn = q_nope.reshape(B, nqb, Q_BLOCK, H, MLA_NOPE).transpose(1, 0, 3, 2, 4)
    qr = q_rope.reshape(B, nqb, Q_BLOCK, H, MLA_ROPE).transpose(1, 0, 3, 2, 4)
    k_chunk = jnp.arange(S) // CHUNK

    def block(args):
        qn_b, qr_b, start = args
        s = (jnp.einsum('bhqd,bkhd->bhqk', qn_b, k_nope)
             + jnp.einsum('bhqd,bkd->bhqk', qr_b, k_rope)).astype(jnp.float32) * scale
        q_chunk = (start + jnp.arange(Q_BLOCK)) // CHUNK
        mask = k_chunk[None, :] <= q_chunk[:, None]
        p = jax.nn.softmax(jnp.where(mask, s, -jnp.inf), axis=-1).astype(v.dtype)
        return jnp.einsum('bhqk,bkhd->bqhd', p, v)

    out = lax.map(block, (qn, qr, jnp.arange(nqb, dtype=jnp.int32) * Q_BLOCK))
    return out.transpose(1, 0, 2, 3, 4).reshape(B, S, H * MLA_DV)


def setup_inputs(seed: int = 0) -> dict:
    key = jax.random.key(seed)
    ks = jax.random.split(key, 16)
    f32 = jnp.float32
    x = jax.random.normal(ks[0], (BATCH, SEQ, D_MODEL), f32)
    offset = jax.random.randint(ks[1], (BATCH, 1), 0, 1024, dtype=jnp.int32)
    positions = offset + jnp.arange(SEQ, dtype=jnp.int32)[None, :]
    col_scale = jnp.concatenate([
        jnp.ones((2 * RET_QK,), f32),
        jnp.full((RET_WIDTH,), DEEPNORM_BETA, f32),
        jnp.ones((IN_WIDTH - 2 * RET_QK - RET_WIDTH,), f32)])
    w_in = jax.random.normal(ks[2], (DEPTH, D_MODEL, IN_WIDTH), f32) * (D_MODEL ** -0.5) * col_scale
    q_norm_g = 1.0 + 0.02 * jax.random.normal(ks[3], (DEPTH, MLA_Q_RANK), f32)
    w_uq = jax.random.normal(ks[4], (DEPTH, MLA_Q_RANK, MLA_HEADS * (MLA_NOPE + MLA_ROPE)), f32) * (MLA_Q_RANK ** -0.5)
    kv_norm_g = 1.0 + 0.02 * jax.random.normal(ks[5], (DEPTH, MLA_KV_RANK), f32)
    w_uk = jax.random.normal(ks[6], (DEPTH, MLA_KV_RANK, MLA_HEADS * MLA_NOPE), f32) * (MLA_KV_RANK ** -0.5)
    w_uv = jax.random.normal(ks[7], (DEPTH, MLA_KV_RANK, MLA_HEADS * MLA_DV), f32) * (MLA_KV_RANK ** -0.5) * DEEPNORM_BETA
    ret_gn_g = 1.0 + 0.02 * jax.random.normal(ks[8], (DEPTH, RET_WIDTH), f32)
    w_out = jax.random.normal(ks[9], (DEPTH, MIX_WIDTH, D_MODEL), f32) * (MIX_WIDTH ** -0.5) * DEEPNORM_BETA
    ln1_g = 1.0 + 0.02 * jax.random.normal(ks[10], (DEPTH, D_MODEL), f32)
    ln1_b = 0.02 * jax.random.normal(ks[11], (DEPTH, D_MODEL), f32)
    w_up = jax.random.normal(ks[12], (DEPTH, D_MODEL, D_FF), f32) * (D_MODEL ** -0.5) * DEEPNORM_BETA
    w_down = jax.random.normal(ks[13], (DEPTH, D_FF, D_MODEL), f32) * (D_FF ** -0.5) * DEEPNORM_BETA
    ln2_g = 1.0 + 0.02 * jax.random.normal(ks[14], (DEPTH, D_MODEL), f32)
    ln2_b = 0.02 * jax.random.normal(ks[15], (DEPTH, D_MODEL), f32)
    return {'x': x, 'positions': positions, 'w_in': w_in, 'q_norm_g': q_norm_g, 'w_uq': w_uq,
            'kv_norm_g': kv_norm_g, 'w_uk': w_uk, 'w_uv': w_uv, 'ret_gn_g': ret_gn_g,
            'w_out': w_out, 'ln1_g': ln1_g, 'ln1_b': ln1_b, 'w_up': w_up, 'w_down': w_down,
            'ln2_g': ln2_g, 'ln2_b': ln2_b}


def reference(x, positions, w_in, q_norm_g, w_uq, kv_norm_g, w_uk, w_uv, ret_gn_g,
              w_out, ln1_g, ln1_b, w_up, w_down, ln2_g, ln2_b):
    B, S, _ = x.shape
    split_idx = [int(i) for i in np.cumsum(IN_SIZES)[:-1]]
    for l in range(DEPTH):
        proj = x @ w_in[l]
        rq, rk, rv, rg, cq, ckv, kr = jnp.split(proj, split_idx, axis=-1)
        rq = _rope(rq.reshape(B, S, RET_HEADS, RET_DK), positions)
        rk = _rope(rk.reshape(B, S, RET_HEADS, RET_DK), positions)
        ret = _retention(rq, rk, rv.reshape(B, S, RET_HEADS, RET_DV)).astype(jnp.float32)
        mu = jnp.mean(ret, axis=-1, keepdims=True)
        var = jnp.mean(jnp.square(ret - mu), axis=-1, keepdims=True)
        ret = ((ret - mu) * lax.rsqrt(var + EPS)).reshape(B, S, RET_WIDTH) * ret_gn_g[l]
        ret_out = (jax.nn.silu(rg.astype(jnp.float32)) * ret).astype(x.dtype)
        mla_out = _mla(cq, ckv, kr, positions, q_norm_g[l], w_uq[l], kv_norm_g[l], w_uk[l], w_uv[l])
        mix = jnp.concatenate([ret_out, mla_out], axis=-1) @ w_out[l]
        x = _layer_norm(DEEPNORM_ALPHA * x + mix, ln1_g[l], ln1_b[l])
        h = jnp.square(jax.nn.relu(x @ w_up[l])) @ w_down[l]
        x = _layer_norm(DEEPNORM_ALPHA * x + h, ln2_g[l], ln2_b[l])
    return x
```

```cpp
#include <hip/hip_runtime.h>
#include <hip/hip_cooperative_groups.h>
#include <cstdio>
#include <cstdint>
namespace cg = cooperative_groups;

typedef unsigned short bf16_t;
typedef short bf16x8 __attribute__((ext_vector_type(8)));
typedef float f32x16 __attribute__((ext_vector_type(16)));
typedef float f32x4 __attribute__((ext_vector_type(4)));
typedef unsigned u32x4 __attribute__((ext_vector_type(4)));
typedef unsigned u32x2 __attribute__((ext_vector_type(2)));

constexpr int NB = 4, SEQ = 4096, T = NB * SEQ, DM = 2048;
constexpr int CH = 64, NCH = SEQ / CH;
constexpr int RH = 8, RD = 128;
constexpr int MH = 8, NOPE = 128, ROPE = 64, MDV = 128, QKD = NOPE + ROPE;
constexpr int QR = 768, KVR = 512;
constexpr int INW = 5440, INWP = 5632;
constexpr int DFF = 8192;
constexpr int C_RQ = 0, C_RK = 1024, C_RV = 2048, C_RG = 3072, C_CQ = 4096, C_CKV = 4864, C_KR = 5376;
constexpr float EPS = 1e-5f;
constexpr float ALPHA = 1.189207115002721f;
constexpr float MLA_SCALE_LOG2E = 0.07216878364870322f * 1.4426950408889634f;
constexpr float RK_SCALE = 0.08838834764831845f;

constexpr size_t MiB = 1u << 20;
constexpr size_t WS_WIN = 1 * MiB;
constexpr size_t WS_WUQ = 23 * MiB;
constexpr size_t WS_WUKV = 26 * MiB;
constexpr size_t WS_WOUT = 28 * MiB;
constexpr size_t WS_WUP = 36 * MiB;
constexpr size_t WS_WDN = 68 * MiB;
constexpr size_t WS_R128 = 100 * MiB;
constexpr size_t WS_R64 = 108 * MiB;
constexpr size_t WS_RINVQ = 112 * MiB;
constexpr size_t WS_RINVKV = 112 * MiB + 65536;
constexpr size_t WS_XB = 113 * MiB;
constexpr size_t WS_SP = 113 * MiB;
constexpr size_t WS_RQ = 177 * MiB, WS_RK = 209 * MiB, WS_RV = 241 * MiB, WS_RG = 273 * MiB;
constexpr size_t WS_MQ = 305 * MiB;
constexpr size_t WS_MKN = 353 * MiB;
constexpr size_t WS_KR = 385 * MiB;
constexpr size_t WS_MV = 387 * MiB;
constexpr size_t WS_CQ = 419 * MiB;
constexpr size_t WS_CKV = 443 * MiB;
constexpr size_t WS_MIX = 448 * MiB;
constexpr size_t WS_X1B = 448 * MiB;
constexpr size_t WS_HDN = 113 * MiB;
constexpr size_t WS_END = 512 * MiB;

constexpr int NTHREADS = 512;
constexpr int LDS_BYTES = 147456;

struct Params {
    const float* x; const int* pos; const float* w_in; const float* q_norm_g; const float* w_uq; const float* kv_norm_g;
    const float* w_uk; const float* w_uv; const float* ret_gn_g; const float* w_out; const float* ln1_g; const float* ln1_b;
    const float* w_up; const float* w_down; const float* ln2_g; const float* ln2_b;
    float* out; unsigned char* ws;
    int ph_lo, ph_hi;
};

__device__ __forceinline__ unsigned f2bf(float f) { unsigned u = __float_as_uint(f); return (u + 0x7fffu + ((u >> 16) & 1u)) >> 16; }
__device__ __forceinline__ float bf2f(unsigned v) { return __uint_as_float(v << 16); }
__device__ __forceinline__ unsigned pk2(float lo, float hi) { return f2bf(lo) | (f2bf(hi) << 16); }
__device__ __forceinline__ int crow(int r, int hi) { return (r & 3) + 8 * (r >> 2) + 4 * hi; }
__device__ __forceinline__ float wave_sum(float v) {
#pragma unroll
    for (int o = 1; o < 64; o <<= 1) v += __shfl_xor(v, o);
    return v;
}
__device__ __forceinline__ float wave_max(float v) {
#pragma unroll
    for (int o = 1; o < 64; o <<= 1) v = fmaxf(v, __shfl_xor(v, o));
    return v;
}

__device__ __forceinline__ void prep_wt(const float* W, int K, int N, int Npad, bf16_t* Wt, int row_off, const float* kg, float sall, int slo, int shi, float sr, float* lds) {
    const int tid = threadIdx.x;
    const int nkt = K / 64, nnt = Npad / 64;
    for (int it = blockIdx.x; it < nkt * nnt; it += gridDim.x) {
        const int kt = it / nnt, nt = it % nnt, k0 = kt * 64, n0 = nt * 64;
        __syncthreads();
        for (int e = tid; e < 4096; e += NTHREADS) {
            const int kk = e >> 6, nn = e & 63; const int n = n0 + nn;
            float v = 0.f;
            if (n < N) { v = W[(size_t)(k0 + kk) * N + n]; if (kg) v *= kg[k0 + kk]; if (n >= slo && n < shi) v *= sr; v *= sall; }
            lds[kk * 65 + nn] = v;
        }
        __syncthreads();
        for (int e = tid; e < 2048; e += NTHREADS) {
            const int nn = e >> 5, kp = (e & 31) * 2;
            const unsigned w = pk2(lds[kp * 65 + nn], lds[(kp + 1) * 65 + nn]);
            *(unsigned*)(Wt + (size_t)(row_off + n0 + nn) * K + k0 + kp) = w;
        }
    }
}
__device__ __forceinline__ void phase_prep(const Params& p, unsigned char* ldsb) {
    float* lds = (float*)ldsb;
    unsigned char* ws = p.ws;
    prep_wt(p.w_in, DM, INW, INWP, (bf16_t*)(ws + WS_WIN), 0, nullptr, 1.f, C_RK, C_RV, RK_SCALE, lds);
    prep_wt(p.w_uq, QR, MH * QKD, MH * QKD, (bf16_t*)(ws + WS_WUQ), 0, p.q_norm_g, MLA_SCALE_LOG2E, 0, 0, 1.f, lds);
    prep_wt(p.w_uk, KVR, MH * NOPE, MH * NOPE, (bf16_t*)(ws + WS_WUKV), 0, p.kv_norm_g, 1.f, 0, 0, 1.f, lds);
    prep_wt(p.w_uv, KVR, MH * MDV, MH * MDV, (bf16_t*)(ws + WS_WUKV), MH * NOPE, p.kv_norm_g, 1.f, 0, 0, 1.f, lds);
    prep_wt(p.w_out, DM, DM, DM, (bf16_t*)(ws + WS_WOUT), 0, nullptr, 1.f, 0, 0, 1.f, lds);
    prep_wt(p.w_up, DM, DFF, DFF, (bf16_t*)(ws + WS_WUP), 0, nullptr, 1.f, 0, 0, 1.f, lds);
    prep_wt(p.w_down, DFF, DM, DM, (bf16_t*)(ws + WS_WDN), 0, nullptr, 1.f, 0, 0, 1.f, lds);
    const size_t gtid = (size_t)blockIdx.x * NTHREADS + threadIdx.x, gsz = (size_t)gridDim.x * NTHREADS;
    bf16_t* xb = (bf16_t*)(ws + WS_XB);
    for (size_t i = gtid; i < (size_t)T * DM / 8; i += gsz) {
        const f32x4 a = *(const f32x4*)(p.x + i * 8), b = *(const f32x4*)(p.x + i * 8 + 4);
        u32x4 w; w.x = pk2(a.x, a.y); w.y = pk2(a.z, a.w); w.z = pk2(b.x, b.y); w.w = pk2(b.z, b.w);
        *(u32x4*)(xb + i * 8) = w;
    }
    float2* r128 = (float2*)(ws + WS_R128); float2* r64 = (float2*)(ws + WS_R64);
    for (size_t i = gtid; i < (size_t)T * 64; i += gsz) {
        const int t = (int)(i >> 6), f = (int)(i & 63);
        const float inv = powf(10000.f, -(float)(2 * f) / 128.f);
        const float ang = (float)p.pos[t] * inv;
        r128[i] = make_float2(cosf(ang), sinf(ang));
    }
    for (size_t i = gtid; i < (size_t)T * 32; i += gsz) {
        const int t = (int)(i >> 5), f = (int)(i & 31);
        const float inv = powf(10000.f, -(float)(2 * f) / 64.f);
        const float ang = (float)p.pos[t] * inv;
        r64[i] = make_float2(cosf(ang), sinf(ang));
    }
}

template <class Epi>
__device__ __forceinline__ void gemm_simple(const bf16_t* A, int lda, const bf16_t* Bt, int M, int N, int K, const Epi& epi) {
    const int tid = threadIdx.x, wid = tid >> 6, lane = tid & 63, r32 = lane & 31, hi = lane >> 5;
    const int nmt = M / 256, nnt = N / 128;
    for (int it = blockIdx.x; it < nmt * nnt; it += gridDim.x) {
        const int tm = it / nnt, tn = it % nnt;
        const int row0 = tm * 256 + wid * 32, col0 = tn * 128;
        f32x16 acc[4];
#pragma unroll
        for (int nb = 0; nb < 4; ++nb)
#pragma unroll
            for (int r = 0; r < 16; ++r) acc[nb][r] = 0.f;
        const bf16_t* ap = A + (size_t)(row0 + r32) * lda + 8 * hi;
        const bf16_t* bp = Bt + (size_t)(col0 + r32) * K + 8 * hi;
        for (int k = 0; k < K; k += 16) {
            const bf16x8 a = *(const bf16x8*)(ap + k);
#pragma unroll
            for (int nb = 0; nb < 4; ++nb) {
                const bf16x8 b = *(const bf16x8*)(bp + (size_t)nb * 32 * K + k);
                acc[nb] = __builtin_amdgcn_mfma_f32_32x32x16_bf16(a, b, acc[nb], 0, 0, 0);
            }
        }
        epi(acc, row0, col0, r32, hi);
    }
}

struct EpiProj {
    bf16_t *rq, *rk, *rv, *rg, *cq, *ckv, *kr; const float2* r128; const float2* r64;
    __device__ __forceinline__ void operator()(const f32x16 (&acc)[4], int row0, int col0, int r32, int hi) const {
        if (col0 < C_RV) {
            bf16_t* dst = (col0 < C_RK) ? rq : rk; const int cbase = (col0 < C_RK) ? col0 : col0 - C_RK;
#pragma unroll
            for (int r = 0; r < 16; ++r) { const int row = row0 + crow(r, hi);
#pragma unroll
                for (int nb = 0; nb < 2; ++nb) { const int i = 32 * nb + r32; const float2 cs = r128[(size_t)row * 64 + i];
                    const float x1 = acc[nb][r], x2 = acc[nb + 2][r];
                    dst[(size_t)row * 1024 + cbase + i] = (bf16_t)f2bf(x1 * cs.x - x2 * cs.y);
                    dst[(size_t)row * 1024 + cbase + 64 + i] = (bf16_t)f2bf(x1 * cs.y + x2 * cs.x); } }
        } else if (col0 < C_CQ) {
            bf16_t* dst = (col0 < C_RG) ? rv : rg; const int cbase = (col0 < C_RG) ? col0 - C_RV : col0 - C_RG;
#pragma unroll
            for (int r = 0; r < 16; ++r) { const int row = row0 + crow(r, hi);
#pragma unroll
                for (int nb = 0; nb < 4; ++nb) dst[(size_t)row * 1024 + cbase + 32 * nb + r32] = (bf16_t)f2bf(acc[nb][r]); }
        } else if (col0 < C_CKV) {
#pragma unroll
            for (int r = 0; r < 16; ++r) { const int row = row0 + crow(r, hi);
#pragma unroll
                for (int nb = 0; nb < 4; ++nb) cq[(size_t)row * QR + (col0 - C_CQ) + 32 * nb + r32] = (bf16_t)f2bf(acc[nb][r]); }
        } else if (col0 < C_KR) {
#pragma unroll
            for (int r = 0; r < 16; ++r) { const int row = row0 + crow(r, hi);
#pragma unroll
                for (int nb = 0; nb < 4; ++nb) ckv[(size_t)row * KVR + (col0 - C_CKV) + 32 * nb + r32] = (bf16_t)f2bf(acc[nb][r]); }
        } else if (col0 == C_KR) {
#pragma unroll
            for (int r = 0; r < 16; ++r) { const int row = row0 + crow(r, hi); const float2 cs = r64[(size_t)row * 32 + r32];
                const float x1 = acc[0][r], x2 = acc[1][r];
                kr[(size_t)row * 64 + r32] = (bf16_t)f2bf(x1 * cs.x - x2 * cs.y);
                kr[(size_t)row * 64 + 32 + r32] = (bf16_t)f2bf(x1 * cs.y + x2 * cs.x); }
        }
    }
};
struct EpiQ {
    bf16_t* mq; const float* rinv; const float2* r64;
    __device__ __forceinline__ void operator()(const f32x16 (&acc)[4], int row0, int col0, int r32, int hi) const {
#pragma unroll
        for (int r = 0; r < 16; ++r) { const int row = row0 + crow(r, hi); const float s = rinv[row];
#pragma unroll
            for (int nb = 0; nb < 4; ++nb) { const int cb = col0 + 32 * nb, w = cb % QKD;
                if (w < NOPE) mq[(size_t)row * (MH * QKD) + cb + r32] = (bf16_t)f2bf(acc[nb][r] * s);
                else if (w == NOPE) { if (nb < 3) { const float2 cs = r64[(size_t)row * 32 + r32]; const float x1 = acc[nb][r] * s, x2 = acc[nb < 3 ? nb + 1 : 3][r] * s;
                    mq[(size_t)row * (MH * QKD) + cb + r32] = (bf16_t)f2bf(x1 * cs.x - x2 * cs.y);
                    mq[(size_t)row * (MH * QKD) + cb + 32 + r32] = (bf16_t)f2bf(x1 * cs.y + x2 * cs.x); } } } }
    }
};
struct EpiKV {
    bf16_t *mkn, *mv; const float* rinv;
    __device__ __forceinline__ void operator()(const f32x16 (&acc)[4], int row0, int col0, int r32, int hi) const {
        bf16_t* dst = (col0 < 1024) ? mkn : mv; const int cbase = (col0 < 1024) ? col0 : col0 - 1024;
#pragma unroll
        for (int r = 0; r < 16; ++r) { const int row = row0 + crow(r, hi); const float s = rinv[row];
#pragma unroll
            for (int nb = 0; nb < 4; ++nb) dst[(size_t)row * 1024 + cbase + 32 * nb + r32] = (bf16_t)f2bf(acc[nb][r] * s); }
    }
};
struct EpiResF32 {
    const float* base; float* y;
    __device__ __forceinline__ void operator()(const f32x16 (&acc)[4], int row0, int col0, int r32, int hi) const {
#pragma unroll
        for (int r = 0; r < 16; ++r) { const int row = row0 + crow(r, hi);
#pragma unroll
            for (int nb = 0; nb < 4; ++nb) { const size_t o = (size_t)row * DM + col0 + 32 * nb + r32; y[o] = ALPHA * base[o] + acc[nb][r]; } }
    }
};
struct EpiRelu2 {
    bf16_t* h;
    __device__ __forceinline__ void operator()(const f32x16 (&acc)[4], int row0, int col0, int r32, int hi) const {
#pragma unroll
        for (int r = 0; r < 16; ++r) { const int row = row0 + crow(r, hi);
#pragma unroll
            for (int nb = 0; nb < 4; ++nb) { const float v = fmaxf(acc[nb][r], 0.f); h[(size_t)row * DFF + col0 + 32 * nb + r32] = (bf16_t)f2bf(v * v); } }
    }
};

__device__ __forceinline__ void phase_rinv(const Params& p) {
    const int lane = threadIdx.x & 63, gw = blockIdx.x * 8 + (threadIdx.x >> 6), ngw = gridDim.x * 8;
    const bf16_t* cq = (const bf16_t*)(p.ws + WS_CQ); const bf16_t* ckv = (const bf16_t*)(p.ws + WS_CKV);
    float* rq = (float*)(p.ws + WS_RINVQ); float* rkv = (float*)(p.ws + WS_RINVKV);
    for (int row = gw; row < T; row += ngw) {
        float s = 0.f;
        for (int c = lane; c < QR; c += 64) { const float v = bf2f(cq[(size_t)row * QR + c]); s += v * v; }
        s = wave_sum(s);
        float s2 = 0.f;
        for (int c = lane; c < KVR; c += 64) { const float v = bf2f(ckv[(size_t)row * KVR + c]); s2 += v * v; }
        s2 = wave_sum(s2);
        if (lane == 0) { rq[row] = 1.0f / sqrtf(s / (float)QR + EPS); rkv[row] = 1.0f / sqrtf(s2 / (float)KVR + EPS); }
    }
}

__device__ __forceinline__ float ret_logg(int h) { return log1pf(-exp2f(-5.0f - (float)h)); }
__device__ __forceinline__ void phase_ret_kv(const Params& p, unsigned char* ldsb) {
    float* kd = (float*)ldsb;
    float* vv = kd + 64 * 128;
    const bf16_t* RK = (const bf16_t*)(p.ws + WS_RK); const bf16_t* RV = (const bf16_t*)(p.ws + WS_RV);
    float* KVS = p.out;
    const int tid = threadIdx.x;
    for (int it = blockIdx.x; it < NB * RH * NCH; it += gridDim.x) {
        const int bh = it / NCH, n = it % NCH, b = bh / RH, h = bh % RH;
        const float lg = ret_logg(h);
        const size_t t0 = (size_t)b * SEQ + (size_t)n * CH;
        __syncthreads();
        for (int e = tid; e < 64 * 128; e += NTHREADS) { const int j = e >> 7, d = e & 127;
            kd[e] = bf2f(RK[(t0 + j) * 1024 + h * 128 + d]) * expf(lg * (float)(63 - j));
            vv[e] = bf2f(RV[(t0 + j) * 1024 + h * 128 + d]); }
        __syncthreads();
        const int d = tid >> 2, eg = tid & 3;
        float acc[32];
#pragma unroll
        for (int i = 0; i < 32; ++i) acc[i] = 0.f;
        for (int j = 0; j < 64; ++j) { const float kv = kd[j * 128 + d];
#pragma unroll
            for (int i = 0; i < 32; ++i) acc[i] += kv * vv[j * 128 + eg * 32 + i]; }
        float* dst = KVS + ((size_t)it * 128 + d) * 128 + eg * 32;
#pragma unroll
        for (int i = 0; i < 32; i += 4) *(f32x4*)(dst + i) = (f32x4){acc[i], acc[i + 1], acc[i + 2], acc[i + 3]};
    }
}
__device__ __forceinline__ void phase_ret_scan(const Params& p) {
    const float* KVS = p.out; bf16_t* SP = (bf16_t*)(p.ws + WS_SP);
    const size_t gtid = (size_t)blockIdx.x * NTHREADS + threadIdx.x, gsz = (size_t)gridDim.x * NTHREADS;
    for (size_t i = gtid; i < (size_t)NB * RH * 128 * 128; i += gsz) {
        const int bh = (int)(i >> 14), d = (int)((i >> 7) & 127), e = (int)(i & 127), h = bh % RH;
        const float cd = expf(ret_logg(h) * 64.f);
        float S = 0.f;
        for (int n = 0; n < NCH; ++n) {
            SP[(((size_t)bh * NCH + n) * 128 + e) * 128 + d] = (bf16_t)f2bf(S);
            S = cd * S + KVS[(((size_t)bh * NCH + n) * 128 + d) * 128 + e];
        }
    }
}
__device__ __forceinline__ void phase_ret_out(const Params& p, unsigned char* ldsb) {
    float* q = (float*)ldsb;
    float* k = q + 64 * 128;
    float* v = k + 64 * 129;
    float* sc = v + 64 * 128;
    const bf16_t* RQ = (const bf16_t*)(p.ws + WS_RQ); const bf16_t* RK = (const bf16_t*)(p.ws + WS_RK);
    const bf16_t* RV = (const bf16_t*)(p.ws + WS_RV); const bf16_t* RG = (const bf16_t*)(p.ws + WS_RG);
    const bf16_t* SP = (const bf16_t*)(p.ws + WS_SP); bf16_t* MIX = (bf16_t*)(p.ws + WS_MIX);
    const int tid = threadIdx.x;
    for (int it = blockIdx.x; it < NB * RH * NCH; it += gridDim.x) {
        const int bh = it / NCH, n = it % NCH, b = bh / RH, h = bh % RH;
        const float lg = ret_logg(h);
        const size_t t0 = (size_t)b * SEQ + (size_t)n * CH;
        __syncthreads();
        for (int e = tid; e < 64 * 128; e += NTHREADS) { const int j = e >> 7, d = e & 127; const size_t g = (t0 + j) * 1024 + h * 128 + d;
            q[e] = bf2f(RQ[g]); k[j * 129 + d] = bf2f(RK[g]); v[e] = bf2f(RV[g]); }
        __syncthreads();
        { const int i = tid >> 3, j0 = (tid & 7) * 8;
#pragma unroll 1
          for (int jj = 0; jj < 8; ++jj) { const int j = j0 + jj; float s = 0.f;
#pragma unroll 4
              for (int d = 0; d < 128; ++d) s += q[i * 128 + d] * k[j * 129 + d];
              const int dist = i > j ? i - j : j - i;
              sc[i * 64 + j] = s * expf(lg * (float)dist); } }
        __syncthreads();
        const int i = tid >> 3, e0 = (tid & 7) * 16;
        float acc[16];
#pragma unroll
        for (int ee = 0; ee < 16; ++ee) acc[ee] = 0.f;
        const bf16_t* sp = SP + ((size_t)it * 128 + e0) * 128;
#pragma unroll 1
        for (int d = 0; d < 128; d += 8) {
            float qv[8];
#pragma unroll
            for (int x = 0; x < 8; ++x) qv[x] = q[i * 128 + d + x];
#pragma unroll
            for (int ee = 0; ee < 16; ++ee) { const u32x4 w = *(const u32x4*)(sp + (size_t)ee * 128 + d);
                acc[ee] += qv[0] * bf2f(w.x & 0xffffu) + qv[1] * bf2f(w.x >> 16) + qv[2] * bf2f(w.y & 0xffffu) + qv[3] * bf2f(w.y >> 16)
                         + qv[4] * bf2f(w.z & 0xffffu) + qv[5] * bf2f(w.z >> 16) + qv[6] * bf2f(w.w & 0xffffu) + qv[7] * bf2f(w.w >> 16); }
        }
        const float qdec = expf(lg * (float)(i + 1));
#pragma unroll
        for (int ee = 0; ee < 16; ++ee) acc[ee] *= qdec;
#pragma unroll 2
        for (int j = 0; j < 64; ++j) { const float s = sc[i * 64 + j];
#pragma unroll
            for (int ee = 0; ee < 16; ++ee) acc[ee] += s * v[j * 128 + e0 + ee]; }
        float s1 = 0.f;
#pragma unroll
        for (int ee = 0; ee < 16; ++ee) s1 += acc[ee];
        s1 += __shfl_xor(s1, 1); s1 += __shfl_xor(s1, 2); s1 += __shfl_xor(s1, 4);
        const float mu = s1 * (1.f / 128.f);
        float s2 = 0.f;
#pragma unroll
        for (int ee = 0; ee < 16; ++ee) { const float dd = acc[ee] - mu; s2 += dd * dd; }
        s2 += __shfl_xor(s2, 1); s2 += __shfl_xor(s2, 2); s2 += __shfl_xor(s2, 4);
        const float rstd = 1.0f / sqrtf(s2 * (1.f / 128.f) + EPS);
        const size_t trow = t0 + i;
#pragma unroll
        for (int ee = 0; ee < 16; ++ee) { const int c = h * 128 + e0 + ee;
            const float g = bf2f(RG[trow * 1024 + c]); const float sg = g / (1.f + expf(-g));
            MIX[trow * DM + c] = (bf16_t)f2bf(sg * (acc[ee] - mu) * rstd * p.ret_gn_g[c]); }
    }
}

__device__ __forceinline__ void phase_attn(const Params& p, unsigned char* ldsb) {
    const int tid = threadIdx.x, wid = tid >> 6, lane = tid & 63;
    float* scw = (float*)ldsb + wid * 4096;
    float* qw = (float*)(ldsb + 8 * 16384) + wid * QKD;
    const bf16_t* MQ = (const bf16_t*)(p.ws + WS_MQ); const bf16_t* MKN = (const bf16_t*)(p.ws + WS_MKN);
    const bf16_t* KR = (const bf16_t*)(p.ws + WS_KR); const bf16_t* MV = (const bf16_t*)(p.ws + WS_MV);
    bf16_t* MIX = (bf16_t*)(p.ws + WS_MIX);
    for (int it = blockIdx.x; it < T; it += gridDim.x) {
        const int t = it, h = wid, b = t / SEQ, s = t % SEQ;
        const int kvlen = (s / CH + 1) * CH;
        const size_t tb = (size_t)b * SEQ;
        for (int d = lane; d < QKD; d += 64) qw[d] = bf2f(MQ[(size_t)t * (MH * QKD) + h * QKD + d]);
        asm volatile("s_waitcnt lgkmcnt(0)" ::: "memory");
        float mx = -1e30f;
        for (int j = lane; j < kvlen; j += 64) {
            const bf16_t* kn = MKN + (tb + j) * 1024 + h * 128; const bf16_t* kr = KR + (tb + j) * 64;
            float dot = 0.f;
#pragma unroll 4
            for (int d = 0; d < 128; d += 8) { const u32x4 w = *(const u32x4*)(kn + d);
                dot += qw[d] * bf2f(w.x & 0xffffu) + qw[d + 1] * bf2f(w.x >> 16) + qw[d + 2] * bf2f(w.y & 0xffffu) + qw[d + 3] * bf2f(w.y >> 16)
                     + qw[d + 4] * bf2f(w.z & 0xffffu) + qw[d + 5] * bf2f(w.z >> 16) + qw[d + 6] * bf2f(w.w & 0xffffu) + qw[d + 7] * bf2f(w.w >> 16); }
#pragma unroll 4
            for (int d = 0; d < 64; d += 8) { const u32x4 w = *(const u32x4*)(kr + d); const float* qq = qw + 128 + d;
                dot += qq[0] * bf2f(w.x & 0xffffu) + qq[1] * bf2f(w.x >> 16) + qq[2] * bf2f(w.y & 0xffffu) + qq[3] * bf2f(w.y >> 16)
                     + qq[4] * bf2f(w.z & 0xffffu) + qq[5] * bf2f(w.z >> 16) + qq[6] * bf2f(w.w & 0xffffu) + qq[7] * bf2f(w.w >> 16); }
            scw[j] = dot; mx = fmaxf(mx, dot);
        }
        mx = wave_max(mx);
        float sum = 0.f;
        for (int j = lane; j < kvlen; j += 64) { const float pe = exp2f(scw[j] - mx); scw[j] = pe; sum += pe; }
        sum = wave_sum(sum);
        asm volatile("s_waitcnt lgkmcnt(0)" ::: "memory");
        float o0 = 0.f, o1 = 0.f;
        const bf16_t* vb = MV + tb * 1024 + h * 128 + 2 * lane;
        for (int j = 0; j < kvlen; ++j) { const unsigned w = *(const unsigned*)(vb + (size_t)j * 1024); const float pj = scw[j];
            o0 += pj * bf2f(w & 0xffffu); o1 += pj * bf2f(w >> 16); }
        const float inv = 1.f / sum;
        *(unsigned*)(MIX + (size_t)t * DM + 1024 + h * 128 + 2 * lane) = pk2(o0 * inv, o1 * inv);
        asm volatile("s_waitcnt lgkmcnt(0)" ::: "memory");
    }
}

__device__ __forceinline__ void phase_ln(float* y, const float* g, const float* bta, bf16_t* yb) {
    const int lane = threadIdx.x & 63, gw = blockIdx.x * 8 + (threadIdx.x >> 6), ngw = gridDim.x * 8;
    for (int row = gw; row < T; row += ngw) {
        f32x4* yr = (f32x4*)(y + (size_t)row * DM) + lane;
        f32x4 v[8]; float s = 0.f;
#pragma unroll
        for (int j = 0; j < 8; ++j) { v[j] = yr[64 * j]; s += (v[j].x + v[j].y) + (v[j].z + v[j].w); }
        const float mean = wave_sum(s) * (1.f / DM); float s2 = 0.f;
#pragma unroll
        for (int j = 0; j < 8; ++j) { v[j] = v[j] - mean; s2 += (v[j].x * v[j].x + v[j].y * v[j].y) + (v[j].z * v[j].z + v[j].w * v[j].w); }
        const float rstd = 1.0f / sqrtf(wave_sum(s2) * (1.f / DM) + EPS);
#pragma unroll
        for (int j = 0; j < 8; ++j) { const int c = 4 * lane + 256 * j; const f32x4 gg = *(const f32x4*)(g + c), bb = *(const f32x4*)(bta + c);
            const f32x4 o = v[j] * rstd * gg + bb; yr[64 * j] = o;
            if (yb) { u32x2 w; w.x = pk2(o.x, o.y); w.y = pk2(o.z, o.w); *(u32x2*)(yb + (size_t)row * DM + c) = w; } }
    }
}

__global__ void __launch_bounds__(NTHREADS, 2) mk_fwd(Params p) {
    extern __shared__ __attribute__((aligned(16))) unsigned char lds[];
    cg::grid_group grid = cg::this_grid();
    unsigned char* ws = p.ws;
#define IN(k) (p.ph_lo <= (k) && (k) < p.ph_hi)
#define SEAM(k) do { if (IN(k) && IN((k) + 1)) grid.sync(); } while (0)
    if (IN(0)) phase_prep(p, lds);
    SEAM(0);
    if (IN(1)) { EpiProj e{(bf16_t*)(ws + WS_RQ), (bf16_t*)(ws + WS_RK), (bf16_t*)(ws + WS_RV), (bf16_t*)(ws + WS_RG), (bf16_t*)(ws + WS_CQ), (bf16_t*)(ws + WS_CKV), (bf16_t*)(ws + WS_KR),
                           (const float2*)(ws + WS_R128), (const float2*)(ws + WS_R64)};
        gemm_simple(( const bf16_t*)(ws + WS_XB), DM, (const bf16_t*)(ws + WS_WIN), T, INWP, DM, e); }
    SEAM(1);
    if (IN(2)) phase_rinv(p);
    SEAM(2);
    if (IN(3)) {
        EpiQ eq{(bf16_t*)(ws + WS_MQ), (const float*)(ws + WS_RINVQ), (const float2*)(ws + WS_R64)};
        gemm_simple((const bf16_t*)(ws + WS_CQ), QR, (const bf16_t*)(ws + WS_WUQ), T, MH * QKD, QR, eq);
        EpiKV ek{(bf16_t*)(ws + WS_MKN), (bf16_t*)(ws + WS_MV), (const float*)(ws + WS_RINVKV)};
        gemm_simple((const bf16_t*)(ws + WS_CKV), KVR, (const bf16_t*)(ws + WS_WUKV), T, 2048, KVR, ek);
        phase_ret_kv(p, lds);
    }
    SEAM(3);
    if (IN(4)) { phase_ret_scan(p); phase_attn(p, lds); }
    SEAM(4);
    if (IN(5)) phase_ret_out(p, lds);
    SEAM(5);
    if (IN(6)) { EpiResF32 e{p.x, p.out}; gemm_simple((const bf16_t*)(ws + WS_MIX), DM, (const bf16_t*)(ws + WS_WOUT), T, DM, DM, e); }
    SEAM(6);
    if (IN(7)) phase_ln(p.out, p.ln1_g, p.ln1_b, (bf16_t*)(ws + WS_X1B));
    SEAM(7);
    if (IN(8)) { EpiRelu2 e{(bf16_t*)(ws + WS_HDN)}; gemm_simple((const bf16_t*)(ws + WS_X1B), DM, (const bf16_t*)(ws + WS_WUP), T, DFF, DM, e); }
    SEAM(8);
    if (IN(9)) { EpiResF32 e{p.out, p.out}; gemm_simple((const bf16_t*)(ws + WS_HDN), DFF, (const bf16_t*)(ws + WS_WDN), T, DM, DFF, e); }
    SEAM(9);
    if (IN(10)) phase_ln(p.out, p.ln2_g, p.ln2_b, nullptr);
#undef IN
#undef SEAM
}

extern "C" void kernel_launch(void* const* d_in, const int* in_sizes, int n_in, void* d_out, int out_size, void* d_ws, size_t ws_size, hipStream_t stream) {
    static int grid = 0;
    if (grid == 0) {
        if (n_in != 16 || in_sizes[0] != T * DM || out_size != T * DM || ws_size < WS_END) {
            fprintf(stderr, "kernel_launch: unexpected shapes n_in %d in0 %d out %d ws %zu\n", n_in, n_in > 0 ? in_sizes[0] : -1, out_size, ws_size); grid = -1; return; }
        int dev = 0, cus = 0, per_cu = 0;
        hipGetDevice(&dev); hipDeviceGetAttribute(&cus, hipDeviceAttributeMultiprocessorCount, dev);
        hipFuncSetAttribute((const void*)mk_fwd, hipFuncAttributeMaxDynamicSharedMemorySize, LDS_BYTES);
        hipOccupancyMaxActiveBlocksPerMultiprocessor(&per_cu, (const void*)mk_fwd, NTHREADS, LDS_BYTES);
        if (per_cu < 1) { fprintf(stderr, "kernel_launch: occupancy query says %d blocks per CU\n", per_cu); per_cu = 1; }
        (void)hipGetLastError();
        grid = cus;
    }
    if (grid < 0) return;
    Params p{};
    p.x = (const float*)d_in[0]; p.pos = (const int*)d_in[1]; p.w_in = (const float*)d_in[2]; p.q_norm_g = (const float*)d_in[3];
    p.w_uq = (const float*)d_in[4]; p.kv_norm_g = (const float*)d_in[5]; p.w_uk = (const float*)d_in[6]; p.w_uv = (const float*)d_in[7];
    p.ret_gn_g = (const float*)d_in[8]; p.w_out = (const float*)d_in[9]; p.ln1_g = (const float*)d_in[10]; p.ln1_b = (const float*)d_in[11];
    p.w_up = (const float*)d_in[12]; p.w_down = (const float*)d_in[13]; p.ln2_g = (const float*)d_in[14]; p.ln2_b = (const float*)d_in[15];
    p.out = (float*)d_out; p.ws = (unsigned char*)d_ws; p.ph_lo = 0; p.ph_hi = 11;
    void* args[] = {&p};
    hipError_t e = hipLaunchCooperativeKernel((const void*)mk_fwd, dim3(grid), dim3(NTHREADS), args, LDS_BYTES, stream);
    if (e != hipSuccess) fprintf(stderr, "cooperative launch failed: %s (grid %d)\n", hipGetErrorString(e), grid);
}
```

```cpp
#include <hip/hip_runtime.h>
#include <hip/hip_cooperative_groups.h>
#include <cstdio>
#include <cstdint>
namespace cg = cooperative_groups;

typedef unsigned short bf16_t;
typedef short bf16x8 __attribute__((ext_vector_type(8)));
typedef float f32x16 __attribute__((ext_vector_type(16)));
typedef float f32x4 __attribute__((ext_vector_type(4)));
typedef unsigned u32x4 __attribute__((ext_vector_type(4)));
typedef unsigned u32x2 __attribute__((ext_vector_type(2)));

constexpr int NB = 4, SEQ = 4096, T = NB * SEQ, DM = 2048;
constexpr int CH = 64, NCH = SEQ / CH;
constexpr int RH = 8, RD = 128;
constexpr int MH = 8, NOPE = 128, ROPE = 64, MDV = 128, QKD = NOPE + ROPE;
constexpr int QR = 768, KVR = 512;
constexpr int INW = 5440, INWP = 5632;
constexpr int DFF = 8192;
constexpr int C_RQ = 0, C_RK = 1024, C_RV = 2048, C_RG = 3072, C_CQ = 4096, C_CKV = 4864, C_KR = 5376;
constexpr float EPS = 1e-5f;
constexpr float ALPHA = 1.189207115002721f;
constexpr float MLA_SCALE_LOG2E = 0.07216878364870322f * 1.4426950408889634f;
constexpr float RK_SCALE = 0.08838834764831845f;

constexpr size_t MiB = 1u << 20;
constexpr size_t WS_WIN = 1 * MiB;
constexpr size_t WS_WUQ = 23 * MiB;
constexpr size_t WS_WUKV = 26 * MiB;
constexpr size_t WS_WOUT = 28 * MiB;
constexpr size_t WS_WUP = 36 * MiB;
constexpr size_t WS_WDN = 68 * MiB;
constexpr size_t WS_R128 = 100 * MiB;
constexpr size_t WS_R64 = 108 * MiB;
constexpr size_t WS_RINVQ = 112 * MiB;
constexpr size_t WS_RINVKV = 112 * MiB + 65536;
constexpr size_t WS_XB = 113 * MiB;
constexpr size_t WS_SP = 113 * MiB;
constexpr size_t WS_RQ = 177 * MiB, WS_RK = 209 * MiB, WS_RV = 241 * MiB, WS_RG = 273 * MiB;
constexpr size_t WS_MQ = 305 * MiB;
constexpr size_t WS_MKN = 353 * MiB;
constexpr size_t WS_KR = 385 * MiB;
constexpr size_t WS_MV = 387 * MiB;
constexpr size_t WS_CQ = 419 * MiB;
constexpr size_t WS_CKV = 443 * MiB;
constexpr size_t WS_MIX = 448 * MiB;
constexpr size_t WS_X1B = 448 * MiB;
constexpr size_t WS_HDN = 113 * MiB;
constexpr size_t WS_END = 512 * MiB;

constexpr int NTHREADS = 512;
constexpr int LDS_BYTES = 147456;

struct Params {
    const float* x; const int* pos; const float* w_in; const float* q_norm_g; const float* w_uq; const float* kv_norm_g;
    const float* w_uk; const float* w_uv; const float* ret_gn_g; const float* w_out; const float* ln1_g; const float* ln1_b;
    const float* w_up; const float* w_down; const float* ln2_g; const float* ln2_b;
    float* out; unsigned char* ws;
    int ph_lo, ph_hi;
};

__device__ __forceinline__ unsigned f2bf(float f) { unsigned u = __float_as_uint(f); return (u + 0x7fffu + ((u >> 16) & 1u)) >> 16; }
__device__ __forceinline__ float bf2f(unsigned v) { return __uint_as_float(v << 16); }
__device__ __forceinline__ unsigned pk2(float lo, float hi) { return f2bf(lo) | (f2bf(hi) << 16); }
__device__ __forceinline__ int crow(int r, int hi) { return (r & 3) + 8 * (r >> 2) + 4 * hi; }
__device__ __forceinline__ float wave_sum(float v) {
#pragma unroll
    for (int o = 1; o < 64; o <<= 1) v += __shfl_xor(v, o);
    return v;
}
__device__ __forceinline__ float wave_max(float v) {
#pragma unroll
    for (int o = 1; o < 64; o <<= 1) v = fmaxf(v, __shfl_xor(v, o));
    return v;
}

__device__ __forceinline__ int d128(int p) { return 64 * ((p >> 2) & 1) + 16 * (p >> 5) + 4 * ((p >> 3) & 3) + (p & 3); }
__device__ __forceinline__ int d64(int p) { return 32 * ((p >> 2) & 1) + 16 * (p >> 5) + 4 * ((p >> 3) & 3) + (p & 3); }
template <int MODE> __device__ __forceinline__ int src_col(int r) {
    if (MODE == 1) {
        if (r < C_RV) return (r & ~127) + d128(r & 127);
        if (r < C_KR) return r;
        if (r < INW) return C_KR + d64(r - C_KR);
        return -1;
    } else if (MODE == 2) {
        if (r < MH * NOPE) return (r >> 7) * QKD + (r & 127);
        const int rr = r - MH * NOPE; return (rr >> 6) * QKD + NOPE + d64(rr & 63);
    }
    return r;
}
template <int MODE>
__device__ __forceinline__ void prep_wt(const float* W, int K, int N, int Npad, bf16_t* Wt, int row_off, const float* kg, float sall, int slo, int shi, float sr, float* lds) {
    const int tid = threadIdx.x;
    const int nkt = K / 64, nnt = Npad / 64;
    for (int it = blockIdx.x; it < nkt * nnt; it += gridDim.x) {
        const int kt = it / nnt, nt = it % nnt, k0 = kt * 64, n0 = nt * 64;
        __syncthreads();
        for (int e = tid; e < 4096; e += NTHREADS) {
            const int kk = e >> 6, nn = e & 63; const int n = n0 + nn; const int sc = src_col<MODE>(n);
            float v = 0.f;
            if (sc >= 0) { v = W[(size_t)(k0 + kk) * N + sc]; if (kg) v *= kg[k0 + kk]; if (n >= slo && n < shi) v *= sr; v *= sall; }
            lds[kk * 65 + nn] = v;
        }
        __syncthreads();
        for (int e = tid; e < 2048; e += NTHREADS) {
            const int nn = e >> 5, kp = (e & 31) * 2;
            const unsigned w = pk2(lds[kp * 65 + nn], lds[(kp + 1) * 65 + nn]);
            *(unsigned*)(Wt + (size_t)(row_off + n0 + nn) * K + k0 + kp) = w;
        }
    }
}
__device__ __forceinline__ void phase_prep(const Params& p, unsigned char* ldsb) {
    float* lds = (float*)ldsb;
    unsigned char* ws = p.ws;
    prep_wt<1>(p.w_in, DM, INW, INWP, (bf16_t*)(ws + WS_WIN), 0, nullptr, 1.f, C_RK, C_RV, RK_SCALE, lds);
    prep_wt<2>(p.w_uq, QR, MH * QKD, MH * QKD, (bf16_t*)(ws + WS_WUQ), 0, p.q_norm_g, MLA_SCALE_LOG2E, 0, 0, 1.f, lds);
    prep_wt<0>(p.w_uk, KVR, MH * NOPE, MH * NOPE, (bf16_t*)(ws + WS_WUKV), 0, p.kv_norm_g, 1.f, 0, 0, 1.f, lds);
    prep_wt<0>(p.w_uv, KVR, MH * MDV, MH * MDV, (bf16_t*)(ws + WS_WUKV), MH * NOPE, p.kv_norm_g, 1.f, 0, 0, 1.f, lds);
    prep_wt<0>(p.w_out, DM, DM, DM, (bf16_t*)(ws + WS_WOUT), 0, nullptr, 1.f, 0, 0, 1.f, lds);
    prep_wt<0>(p.w_up, DM, DFF, DFF, (bf16_t*)(ws + WS_WUP), 0, nullptr, 1.f, 0, 0, 1.f, lds);
    prep_wt<0>(p.w_down, DFF, DM, DM, (bf16_t*)(ws + WS_WDN), 0, nullptr, 1.f, 0, 0, 1.f, lds);
    const size_t gtid = (size_t)blockIdx.x * NTHREADS + threadIdx.x, gsz = (size_t)gridDim.x * NTHREADS;
    bf16_t* xb = (bf16_t*)(ws + WS_XB);
    for (size_t i = gtid; i < (size_t)T * DM / 8; i += gsz) {
        const f32x4 a = *(const f32x4*)(p.x + i * 8), b = *(const f32x4*)(p.x + i * 8 + 4);
        u32x4 w; w.x = pk2(a.x, a.y); w.y = pk2(a.z, a.w); w.z = pk2(b.x, b.y); w.w = pk2(b.z, b.w);
        *(u32x4*)(xb + i * 8) = w;
    }
    float2* r128 = (float2*)(ws + WS_R128); float2* r64 = (float2*)(ws + WS_R64);
    for (size_t i = gtid; i < (size_t)T * 64; i += gsz) {
        const int t = (int)(i >> 6), f = (int)(i & 63);
        const float inv = powf(10000.f, -(float)(2 * f) / 128.f);
        const float ang = (float)p.pos[t] * inv;
        r128[i] = make_float2(cosf(ang), sinf(ang));
    }
    for (size_t i = gtid; i < (size_t)T * 32; i += gsz) {
        const int t = (int)(i >> 5), f = (int)(i & 31);
        const float inv = powf(10000.f, -(float)(2 * f) / 64.f);
        const float ang = (float)p.pos[t] * inv;
        r64[i] = make_float2(cosf(ang), sinf(ang));
    }
}

namespace pg8 {
#define PG8_LAS __attribute__((address_space(3)))
constexpr int BM = 256, BK = 64, HALF = 128, HTB = HALF * BK * 2  , STAGE_BYTES = 8 * HTB, NXCD = 8, WGM = 8;

__host__ __device__ __forceinline__ int lds_byte(int r, int c) { const int st = (r >> 4) * 2 + (c >> 5), rr = r & 15, cc = c & 31, ob = rr * 64 + cc * 2; return st * 1024 + (ob ^ (((ob >> 9) & 1) << 5)); }
__host__ __device__ __forceinline__ void stage_rc(int b, int& R, int& C) { const int st = b / 1024, sb = b % 1024, swz = sb ^ (((sb >> 9) & 1) << 5); R = (st >> 1) * 16 + swz / 64; C = (st & 1) * 32 + (swz % 64) / 2; }
__host__ __device__ __forceinline__ int perm32(int rho) { const int n = rho >> 4, i = rho & 15; return 8 * (i >> 2) + 4 * n + (i & 3); }

struct Unit { int pm, pn; };
struct Gemm { const bf16_t* A; const bf16_t* Bt; int M, N, K; };

struct StaticOrder {
    int nM, nN, nwg, G, c;
    __host__ __device__ void init(int M, int N, int G_, int c_) { nM = M / BM; nN = N / BM; nwg = nM * nN; G = G_; c = c_; }
    __host__ __device__ bool next(int i, Unit& u) const {
        const long L = (long)i * G + c; if (L >= nwg) return false;
        int wgid = (int)L; { const int q = nwg / NXCD, r = nwg % NXCD, xcd = wgid % NXCD, off = wgid / NXCD; wgid = (xcd < r ? xcd * (q + 1) : r * (q + 1) + (xcd - r) * q) + off; }
        const int nig = WGM * nN, gid = wgid / nig, fm = gid * WGM, gsz = (nM - fm) < WGM ? (nM - fm) : WGM;
        u.pm = fm + ((wgid % nig) % gsz); u.pn = (wgid % nig) / gsz; return true;
    }
    __device__ __forceinline__ void a_ready(const Unit&) const {}
    __device__ __forceinline__ void done(const Unit&) const {}
};

__device__ __forceinline__ unsigned cvt_pk_bf16(float lo, float hi) { unsigned r; asm volatile("v_cvt_pk_bf16_f32 %0, %1, %2" : "=v"(r) : "v"(lo), "v"(hi)); return r; }
__device__ __forceinline__ u32x4 pack8(f32x4 v0, f32x4 v1) { u32x4 w; w.x = cvt_pk_bf16(v0[0], v0[1]); w.y = cvt_pk_bf16(v0[2], v0[3]); w.z = cvt_pk_bf16(v1[0], v1[1]); w.w = cvt_pk_bf16(v1[2], v1[3]); return w; }

struct EpiProj {
    static constexpr bool PERM = true, AFTER_DRAIN = false;
    unsigned char* ws;
    __device__ __forceinline__ void operator()(const f32x4 (&acc)[2][2][4][2], const Unit& u, int wr, int wc, int fr, int fq) const {
        const int row0 = u.pm * BM + wr * 64 + fr, pn = u.pn;
        if (pn < 8) {
            const float* r128 = (const float*)(ws + WS_R128);
            bf16_t* dst = (bf16_t*)(ws + (pn < 4 ? WS_RQ : WS_RK)) + (size_t)((pn & 3) * BM + wc * 32 + 8 * fq);
#pragma unroll
            for (int ai = 0; ai < 2; ++ai)
#pragma unroll
                for (int m = 0; m < 4; ++m) { const int row = row0 + ai * HALF + m * 16;
                    const float* tp = r128 + ((size_t)row * 64 + 16 * wc + 4 * fq) * 2; const f32x4 t0 = *(const f32x4*)tp, t1 = *(const f32x4*)(tp + 4);
                    const f32x4 c = {t0[0], t0[2], t1[0], t1[2]}, sn = {t0[1], t0[3], t1[1], t1[3]};
#pragma unroll
                    for (int bj = 0; bj < 2; ++bj) { const f32x4 x1 = acc[ai][bj][m][0], x2 = acc[ai][bj][m][1];
                        *(u32x4*)(dst + (size_t)row * 1024 + bj * HALF) = pack8(x1 * c - x2 * sn, x1 * sn + x2 * c); } }
        } else if (pn < 21) {
            size_t wo; int ld, cb;
            if (pn < 12) { wo = WS_RV; ld = 1024; cb = (pn - 8) * BM; } else if (pn < 16) { wo = WS_RG; ld = 1024; cb = (pn - 12) * BM; }
            else if (pn < 19) { wo = WS_CQ; ld = QR; cb = (pn - 16) * BM; } else { wo = WS_CKV; ld = KVR; cb = (pn - 19) * BM; }
            bf16_t* dst = (bf16_t*)(ws + wo) + cb + wc * 32 + 8 * fq;
#pragma unroll
            for (int ai = 0; ai < 2; ++ai)
#pragma unroll
                for (int m = 0; m < 4; ++m) { const int row = row0 + ai * HALF + m * 16;
#pragma unroll
                    for (int bj = 0; bj < 2; ++bj) *(u32x4*)(dst + (size_t)row * ld + bj * HALF) = pack8(acc[ai][bj][m][0], acc[ai][bj][m][1]); }
        } else if (wc < 2) {
            const float* r64 = (const float*)(ws + WS_R64); bf16_t* kr = (bf16_t*)(ws + WS_KR);
#pragma unroll
            for (int ai = 0; ai < 2; ++ai)
#pragma unroll
                for (int m = 0; m < 4; ++m) { const int row = row0 + ai * HALF + m * 16;
                    const float* tp = r64 + ((size_t)row * 32 + 16 * wc + 4 * fq) * 2; const f32x4 t0 = *(const f32x4*)tp, t1 = *(const f32x4*)(tp + 4);
                    const f32x4 c = {t0[0], t0[2], t1[0], t1[2]}, sn = {t0[1], t0[3], t1[1], t1[3]};
                    const f32x4 x1 = acc[ai][0][m][0], x2 = acc[ai][0][m][1];
                    *(u32x4*)(kr + (size_t)row * 64 + wc * 32 + 8 * fq) = pack8(x1 * c - x2 * sn, x1 * sn + x2 * c); }
        }
    }
};
struct EpiQ {
    static constexpr bool PERM = true, AFTER_DRAIN = false;
    bf16_t* mq; const float* rinv; const float* r64;
    __device__ __forceinline__ void operator()(const f32x4 (&acc)[2][2][4][2], const Unit& u, int wr, int wc, int fr, int fq) const {
        const int row0 = u.pm * BM + wr * 64 + fr, pn = u.pn;
        bf16_t* dst = mq + (size_t)(pn * BM + wc * 32 + 8 * fq);
#pragma unroll
        for (int ai = 0; ai < 2; ++ai)
#pragma unroll
            for (int m = 0; m < 4; ++m) { const int row = row0 + ai * HALF + m * 16; const float s = rinv[row];
                if (pn < 4) {
#pragma unroll
                    for (int bj = 0; bj < 2; ++bj) *(u32x4*)(dst + (size_t)row * (MH * QKD) + bj * HALF) = pack8(acc[ai][bj][m][0] * s, acc[ai][bj][m][1] * s);
                } else {
                    const float* tp = r64 + ((size_t)row * 32 + 16 * (wc & 1) + 4 * fq) * 2; const f32x4 t0 = *(const f32x4*)tp, t1 = *(const f32x4*)(tp + 4);
                    const f32x4 c = {t0[0], t0[2], t1[0], t1[2]}, sn = {t0[1], t0[3], t1[1], t1[3]};
#pragma unroll
                    for (int bj = 0; bj < 2; ++bj) { const f32x4 x1 = acc[ai][bj][m][0] * s, x2 = acc[ai][bj][m][1] * s;
                        *(u32x4*)(dst + (size_t)row * (MH * QKD) + bj * HALF) = pack8(x1 * c - x2 * sn, x1 * sn + x2 * c); }
                } }
    }
};
struct EpiKV {
    static constexpr bool PERM = true, AFTER_DRAIN = false;
    unsigned char* ws; const float* rinv;
    __device__ __forceinline__ void operator()(const f32x4 (&acc)[2][2][4][2], const Unit& u, int wr, int wc, int fr, int fq) const {
        const int row0 = u.pm * BM + wr * 64 + fr, pn = u.pn;
        bf16_t* dst = (bf16_t*)(ws + (pn < 4 ? WS_MKN : WS_MV)) + (size_t)((pn & 3) * BM + wc * 32 + 8 * fq);
#pragma unroll
        for (int ai = 0; ai < 2; ++ai)
#pragma unroll
            for (int m = 0; m < 4; ++m) { const int row = row0 + ai * HALF + m * 16; const float s = rinv[row];
#pragma unroll
                for (int bj = 0; bj < 2; ++bj) *(u32x4*)(dst + (size_t)row * 1024 + bj * HALF) = pack8(acc[ai][bj][m][0] * s, acc[ai][bj][m][1] * s); }
    }
};
struct EpiResF32 {
    static constexpr bool PERM = false, AFTER_DRAIN = false;
    const float* base; float* y;
    __device__ __forceinline__ void operator()(const f32x4 (&acc)[2][2][4][2], const Unit& u, int wr, int wc, int fr, int fq) const {
        const int row0 = u.pm * BM + wr * 64 + fr, col0 = u.pn * BM + wc * 32 + 4 * fq;
#pragma unroll
        for (int ai = 0; ai < 2; ++ai)
#pragma unroll
            for (int m = 0; m < 4; ++m) { const size_t off = (size_t)(row0 + ai * HALF + m * 16) * DM + col0;
#pragma unroll
                for (int bj = 0; bj < 2; ++bj)
#pragma unroll
                    for (int n = 0; n < 2; ++n) { const f32x4 b = *(const f32x4*)(base + off + bj * HALF + n * 16); *(f32x4*)(y + off + bj * HALF + n * 16) = b * ALPHA + acc[ai][bj][m][n]; } }
    }
};
struct EpiRelu2 {
    static constexpr bool PERM = true, AFTER_DRAIN = false;
    bf16_t* h;
    __device__ __forceinline__ void operator()(const f32x4 (&acc)[2][2][4][2], const Unit& u, int wr, int wc, int fr, int fq) const {
        const int row0 = u.pm * BM + wr * 64 + fr;
        bf16_t* dst = h + (size_t)(u.pn * BM + wc * 32 + 8 * fq);
        const f32x4 z = {0.f, 0.f, 0.f, 0.f};
#pragma unroll
        for (int ai = 0; ai < 2; ++ai)
#pragma unroll
            for (int m = 0; m < 4; ++m) { const int row = row0 + ai * HALF + m * 16;
#pragma unroll
                for (int bj = 0; bj < 2; ++bj) { const f32x4 a = __builtin_elementwise_max(acc[ai][bj][m][0], z), b = __builtin_elementwise_max(acc[ai][bj][m][1], z);
                    *(u32x4*)(dst + (size_t)row * DFF + bj * HALF) = pack8(a * a, b * b); } }
    }
};

template <class Epi, class Sched, bool ALIGN_EPI = false, bool SP2 = false>
__device__ __forceinline__ void gemm_phase(PG8_LAS unsigned char* lds, const Gemm g, const Sched& S, const Epi& E) {
    const int tid = threadIdx.x, wid = __builtin_amdgcn_readfirstlane(tid >> 6), lane = tid & 63, wr = wid >> 2, wc = wid & 3, fr = lane & 15, fq = lane >> 4;
    const int K = g.K, nt = K / BK;
    unsigned voffA[2], voffB[2];
#pragma unroll
    for (int i = 0; i < 2; ++i) { int R, C; stage_rc(tid * 16 + i * 8192, R, C); const int Rb = Epi::PERM ? ((R & ~31) + perm32(R & 31)) : R;
        voffA[i] = (unsigned)(R * K + C) * 2u; voffB[i] = (unsigned)(Rb * K + C) * 2u; }
    const size_t kstep = (size_t)(BK * 2);
    const size_t hstep = (size_t)HALF * K * 2;
    const size_t tstep = 2 * hstep;
    const unsigned ldsw = (unsigned)wid * 1024u;
    const int aoff = lds_byte(wr * 64 + fr, fq * 8), boff = lds_byte(wc * 32 + fr, fq * 8);
#define PG8_SA(b, h) (((b) * 2 + (h)) * HTB)
#define PG8_SB(b, h) ((4 + (b) * 2 + (h)) * HTB)
#define PG8_STAGE(bufoff, gbase, voff) do { _Pragma("unroll") for (int _i = 0; _i < 2; ++_i) \
        __builtin_amdgcn_global_load_lds((const unsigned*)((const char*)(gbase) + (voff)[_i]), (PG8_LAS unsigned*)(lds + (bufoff) + ldsw + _i * 8192), 16, 0, 0); } while (0)
#define PG8_LDA(dst, b, h) do { _Pragma("unroll") for (int m = 0; m < 4; ++m) _Pragma("unroll") for (int k = 0; k < 2; ++k) dst[m][k] = *(const PG8_LAS bf16x8*)(lds + PG8_SA(b, h) + aoff + m * 2048 + k * 1024); } while (0)
#define PG8_LDB(dst, b, h) do { _Pragma("unroll") for (int n = 0; n < 2; ++n) _Pragma("unroll") for (int k = 0; k < 2; ++k) dst[n][k] = *(const PG8_LAS bf16x8*)(lds + PG8_SB(b, h) + boff + n * 2048 + k * 1024); } while (0)
#define PG8_MMA(ai, bj, At, Bt) do { __builtin_amdgcn_s_setprio(1); _Pragma("unroll") for (int m = 0; m < 4; ++m) _Pragma("unroll") for (int n = 0; n < 2; ++n) _Pragma("unroll") for (int k = 0; k < 2; ++k) \
        acc[ai][bj][m][n] = __builtin_amdgcn_mfma_f32_16x16x32_bf16(Bt[n][k], At[m][k], acc[ai][bj][m][n], 0, 0, 0); __builtin_amdgcn_s_setprio(0); } while (0)
#define PG8_WAIT_V(n) asm volatile("s_waitcnt vmcnt(" #n ")" ::: "memory")
#define PG8_WAIT_L(n) asm volatile("s_waitcnt lgkmcnt(" #n ")" ::: "memory")
#define PG8_BAR __builtin_amdgcn_s_barrier()
#define PG8_SCHED __builtin_amdgcn_sched_barrier(0)
    Unit cur, nxt; int ui = 0;
    if (!S.next(0, cur)) return;
    f32x4 acc[2][2][4][2];
#pragma unroll
    for (int a = 0; a < 2; ++a)
#pragma unroll
        for (int b = 0; b < 2; ++b)
#pragma unroll
            for (int m = 0; m < 4; ++m)
#pragma unroll
                for (int n = 0; n < 2; ++n) acc[a][b][m][n] = (f32x4){0.f, 0.f, 0.f, 0.f};
    bf16x8 At[4][2], B0[2][2], B1[2][2];
    const char* cA = (const char*)g.A + (size_t)cur.pm * tstep; const char* cB = (const char*)g.Bt + (size_t)cur.pn * tstep;
    S.a_ready(cur);
    if constexpr (SP2) {
        PG8_STAGE(PG8_SB(0, 0), cB, voffB); PG8_STAGE(PG8_SB(0, 1), cB + hstep, voffB); PG8_STAGE(PG8_SA(0, 0), cA, voffA); PG8_STAGE(PG8_SA(0, 1), cA + hstep, voffA);
        if (wr == 1) PG8_BAR;
        PG8_WAIT_V(2); PG8_BAR;
        PG8_STAGE(PG8_SB(1, 0), cB + kstep, voffB); PG8_STAGE(PG8_SA(1, 0), cA + kstep, voffA); PG8_STAGE(PG8_SB(1, 1), cB + hstep + kstep, voffB);
        PG8_WAIT_V(6); PG8_BAR;
    } else {
        PG8_STAGE(PG8_SB(0, 0), cB, voffB); PG8_STAGE(PG8_SA(0, 0), cA, voffA); PG8_STAGE(PG8_SB(0, 1), cB + hstep, voffB); PG8_STAGE(PG8_SA(0, 1), cA + hstep, voffA);
        if (wr == 1) PG8_BAR;
        PG8_WAIT_V(4); PG8_BAR;
        PG8_STAGE(PG8_SB(1, 0), cB + kstep, voffB); PG8_STAGE(PG8_SA(1, 0), cA + kstep, voffA); PG8_STAGE(PG8_SB(1, 1), cB + hstep + kstep, voffB);
        PG8_WAIT_V(6); PG8_BAR;
    }
    for (;;) {
        const bool has_next = S.next(ui + 1, nxt);
        const char* nA = has_next ? (const char*)g.A + (size_t)nxt.pm * tstep : cA; const char* nB = has_next ? (const char*)g.Bt + (size_t)nxt.pn * tstep : cB;
        for (int t = 0; t < nt; t += 2) {
            const bool last = (t == nt - 2);
            const char* a1 = cA + (size_t)(t + 1) * kstep;
            const char* a2 = last ? nA : cA + (size_t)(t + 2) * kstep; const char* b2 = last ? nB : cB + (size_t)(t + 2) * kstep;
            const char* a3 = a2 + kstep; const char* b3 = b2 + kstep;
            if (last && has_next) S.a_ready(nxt);
            if constexpr (SP2) {
            PG8_LDB(B0, 0, 0); PG8_LDB(B1, 0, 1); PG8_SCHED; PG8_LDA(At, 0, 0); PG8_STAGE(PG8_SA(1, 1), a1 + hstep, voffA);
            PG8_WAIT_V(8); PG8_WAIT_L(0); PG8_BAR; PG8_MMA(0, 0, At, B0); PG8_MMA(0, 1, At, B1); PG8_BAR; PG8_SCHED;
            PG8_LDA(At, 0, 1); PG8_STAGE(PG8_SB(0, 0), b2, voffB); PG8_STAGE(PG8_SB(0, 1), b2 + hstep, voffB); PG8_STAGE(PG8_SA(0, 0), a2, voffA);
            PG8_WAIT_V(8); PG8_WAIT_L(0); PG8_BAR; PG8_MMA(1, 0, At, B0); PG8_MMA(1, 1, At, B1); PG8_BAR; PG8_SCHED;
            PG8_LDB(B0, 1, 0); PG8_LDB(B1, 1, 1); PG8_SCHED; PG8_LDA(At, 1, 0); PG8_STAGE(PG8_SA(0, 1), a2 + hstep, voffA);
            PG8_WAIT_V(8); PG8_WAIT_L(0); PG8_BAR; PG8_MMA(0, 0, At, B0); PG8_MMA(0, 1, At, B1); PG8_BAR; PG8_SCHED;
            PG8_LDA(At, 1, 1); PG8_STAGE(PG8_SB(1, 0), b3, voffB); PG8_STAGE(PG8_SB(1, 1), b3 + hstep, voffB); PG8_STAGE(PG8_SA(1, 0), a3, voffA);
            PG8_WAIT_V(8); PG8_WAIT_L(0); PG8_BAR; PG8_MMA(1, 0, At, B0); PG8_MMA(1, 1, At, B1); PG8_BAR; PG8_SCHED;
            } else {
            PG8_LDB(B0, 0, 0); PG8_SCHED; PG8_LDA(At, 0, 0); PG8_STAGE(PG8_SA(1, 1), a1 + hstep, voffA);
            PG8_WAIT_L(8); PG8_BAR; PG8_WAIT_L(0); PG8_MMA(0, 0, At, B0); PG8_BAR; PG8_SCHED;
            PG8_LDB(B1, 0, 1); PG8_STAGE(PG8_SB(0, 0), b2, voffB);
            PG8_BAR; PG8_WAIT_L(0); PG8_MMA(0, 1, At, B1); PG8_BAR;
            PG8_LDA(At, 0, 1); PG8_STAGE(PG8_SA(0, 0), a2, voffA);
            PG8_BAR; PG8_WAIT_L(0); PG8_MMA(1, 0, At, B0); PG8_BAR; PG8_SCHED;
            PG8_STAGE(PG8_SB(0, 1), b2 + hstep, voffB);
            PG8_WAIT_V(6); PG8_BAR; PG8_MMA(1, 1, At, B1); PG8_BAR;
            PG8_LDB(B0, 1, 0); PG8_SCHED; PG8_LDA(At, 1, 0); PG8_STAGE(PG8_SA(0, 1), a2 + hstep, voffA);
            PG8_WAIT_L(8); PG8_BAR; PG8_WAIT_L(0); PG8_MMA(0, 0, At, B0); PG8_BAR; PG8_SCHED;
            PG8_LDB(B1, 1, 1); PG8_STAGE(PG8_SB(1, 0), b3, voffB);
            PG8_BAR; PG8_WAIT_L(0); PG8_MMA(0, 1, At, B1); PG8_BAR;
            PG8_LDA(At, 1, 1); PG8_STAGE(PG8_SA(1, 0), a3, voffA);
            PG8_BAR; PG8_WAIT_L(0); PG8_MMA(1, 0, At, B0); PG8_BAR; PG8_SCHED;
            PG8_STAGE(PG8_SB(1, 1), b3 + hstep, voffB);
            PG8_WAIT_V(6); PG8_BAR; PG8_MMA(1, 1, At, B1); PG8_BAR;
            }
        }
        if constexpr (ALIGN_EPI) { if (wr == 0) PG8_BAR; }
        if constexpr (!Epi::AFTER_DRAIN) { E(acc, cur, wr, wc, fr, fq); S.done(cur); }
        if (!has_next) break;
#pragma unroll
        for (int a = 0; a < 2; ++a)
#pragma unroll
            for (int b = 0; b < 2; ++b)
#pragma unroll
                for (int m = 0; m < 4; ++m)
#pragma unroll
                    for (int n = 0; n < 2; ++n) acc[a][b][m][n] = (f32x4){0.f, 0.f, 0.f, 0.f};
        cur = nxt; cA = nA; cB = nB; ++ui;
        if constexpr (ALIGN_EPI) { if (wr == 1) PG8_BAR; }
    }
    PG8_WAIT_V(0);
    if constexpr (!ALIGN_EPI) { if (wr == 0) PG8_BAR; }
    PG8_BAR;
    if constexpr (Epi::AFTER_DRAIN) { E.fused(acc, cur, wr, wc, fr, fq, lds, wid, lane); S.done(cur); }
#undef PG8_SA
#undef PG8_SB
#undef PG8_STAGE
#undef PG8_LDA
#undef PG8_LDB
#undef PG8_MMA
#undef PG8_WAIT_V
#undef PG8_WAIT_L
#undef PG8_BAR
#undef PG8_SCHED
}
}

__device__ __forceinline__ void phase_rinv(const Params& p) {
    const int lane = threadIdx.x & 63, gw = blockIdx.x * 8 + (threadIdx.x >> 6), ngw = gridDim.x * 8;
    const bf16_t* cq = (const bf16_t*)(p.ws + WS_CQ); const bf16_t* ckv = (const bf16_t*)(p.ws + WS_CKV);
    float* rq = (float*)(p.ws + WS_RINVQ); float* rkv = (float*)(p.ws + WS_RINVKV);
    for (int row = gw; row < T; row += ngw) {
        float s = 0.f;
        for (int c = lane; c < QR; c += 64) { const float v = bf2f(cq[(size_t)row * QR + c]); s += v * v; }
        s = wave_sum(s);
        float s2 = 0.f;
        for (int c = lane; c < KVR; c += 64) { const float v = bf2f(ckv[(size_t)row * KVR + c]); s2 += v * v; }
        s2 = wave_sum(s2);
        if (lane == 0) { rq[row] = 1.0f / sqrtf(s / (float)QR + EPS); rkv[row] = 1.0f / sqrtf(s2 / (float)KVR + EPS); }
    }
}

__device__ __forceinline__ float ret_logg(int h) { return log1pf(-exp2f(-5.0f - (float)h)); }
__device__ __forceinline__ void phase_ret_kv(const Params& p, unsigned char* ldsb) {
    float* kd = (float*)ldsb;
    float* vv = kd + 64 * 128;
    const bf16_t* RK = (const bf16_t*)(p.ws + WS_RK); const bf16_t* RV = (const bf16_t*)(p.ws + WS_RV);
    float* KVS = p.out;
    const int tid = threadIdx.x;
    for (int it = blockIdx.x; it < NB * RH * NCH; it += gridDim.x) {
        const int bh = it / NCH, n = it % NCH, b = bh / RH, h = bh % RH;
        const float lg = ret_logg(h);
        const size_t t0 = (size_t)b * SEQ + (size_t)n * CH;
        __syncthreads();
        for (int e = tid; e < 64 * 128; e += NTHREADS) { const int j = e >> 7, d = e & 127;
            kd[e] = bf2f(RK[(t0 + j) * 1024 + h * 128 + d]) * expf(lg * (float)(63 - j));
            vv[e] = bf2f(RV[(t0 + j) * 1024 + h * 128 + d]); }
        __syncthreads();
        const int d = tid >> 2, eg = tid & 3;
        float acc[32];
#pragma unroll
        for (int i = 0; i < 32; ++i) acc[i] = 0.f;
        for (int j = 0; j < 64; ++j) { const float kv = kd[j * 128 + d];
#pragma unroll
            for (int i = 0; i < 32; ++i) acc[i] += kv * vv[j * 128 + eg * 32 + i]; }
        float* dst = KVS + ((size_t)it * 128 + d) * 128 + eg * 32;
#pragma unroll
        for (int i = 0; i < 32; i += 4) *(f32x4*)(dst + i) = (f32x4){acc[i], acc[i + 1], acc[i + 2], acc[i + 3]};
    }
}
__device__ __forceinline__ void phase_ret_scan(const Params& p) {
    const float* KVS = p.out; bf16_t* SP = (bf16_t*)(p.ws + WS_SP);
    const size_t gtid = (size_t)blockIdx.x * NTHREADS + threadIdx.x, gsz = (size_t)gridDim.x * NTHREADS;
    for (size_t i = gtid; i < (size_t)NB * RH * 128 * 128; i += gsz) {
        const int bh = (int)(i >> 14), d = (int)((i >> 7) & 127), e = (int)(i & 127), h = bh % RH;
        const float cd = expf(ret_logg(h) * 64.f);
        float S = 0.f;
        for (int n = 0; n < NCH; ++n) {
            SP[(((size_t)bh * NCH + n) * 128 + e) * 128 + d] = (bf16_t)f2bf(S);
            S = cd * S + KVS[(((size_t)bh * NCH + n) * 128 + d) * 128 + e];
        }
    }
}
__device__ __forceinline__ void phase_ret_out(const Params& p, unsigned char* ldsb) {
    float* q = (float*)ldsb;
    float* k = q + 64 * 128;
    float* v = k + 64 * 129;
    float* sc = v + 64 * 128;
    const bf16_t* RQ = (const bf16_t*)(p.ws + WS_RQ); const bf16_t* RK = (const bf16_t*)(p.ws + WS_RK);
    const bf16_t* RV = (const bf16_t*)(p.ws + WS_RV); const bf16_t* RG = (const bf16_t*)(p.ws + WS_RG);
    const bf16_t* SP = (const bf16_t*)(p.ws + WS_SP); bf16_t* MIX = (bf16_t*)(p.ws + WS_MIX);
    const int tid = threadIdx.x;
    for (int it = blockIdx.x; it < NB * RH * NCH; it += gridDim.x) {
        const int bh = it / NCH, n = it % NCH, b = bh / RH, h = bh % RH;
        const float lg = ret_logg(h);
        const size_t t0 = (size_t)b * SEQ + (size_t)n * CH;
        __syncthreads();
        for (int e = tid; e < 64 * 128; e += NTHREADS) { const int j = e >> 7, d = e & 127; const size_t g = (t0 + j) * 1024 + h * 128 + d;
            q[e] = bf2f(RQ[g]); k[j * 129 + d] = bf2f(RK[g]); v[e] = bf2f(RV[g]); }
        __syncthreads();
        { const int i = tid >> 3, j0 = (tid & 7) * 8;
#pragma unroll 1
          for (int jj = 0; jj < 8; ++jj) { const int j = j0 + jj; float s = 0.f;
#pragma unroll 4
              for (int d = 0; d < 128; ++d) s += q[i * 128 + d] * k[j * 129 + d];
              const int dist = i > j ? i - j : j - i;
              sc[i * 64 + j] = s * expf(lg * (float)dist); } }
        __syncthreads();
        const int i = tid >> 3, e0 = (tid & 7) * 16;
        float acc[16];
#pragma unroll
        for (int ee = 0; ee < 16; ++ee) acc[ee] = 0.f;
        const bf16_t* sp = SP + ((size_t)it * 128 + e0) * 128;
#pragma unroll 1
        for (int d = 0; d < 128; d += 8) {
            float qv[8];
#pragma unroll
            for (int x = 0; x < 8; ++x) qv[x] = q[i * 128 + d + x];
#pragma unroll
            for (int ee = 0; ee < 16; ++ee) { const u32x4 w = *(const u32x4*)(sp + (size_t)ee * 128 + d);
                acc[ee] += qv[0] * bf2f(w.x & 0xffffu) + qv[1] * bf2f(w.x >> 16) + qv[2] * bf2f(w.y & 0xffffu) + qv[3] * bf2f(w.y >> 16)
                         + qv[4] * bf2f(w.z & 0xffffu) + qv[5] * bf2f(w.z >> 16) + qv[6] * bf2f(w.w & 0xffffu) + qv[7] * bf2f(w.w >> 16); }
        }
        const float qdec = expf(lg * (float)(i + 1));
#pragma unroll
        for (int ee = 0; ee < 16; ++ee) acc[ee] *= qdec;
#pragma unroll 2
        for (int j = 0; j < 64; ++j) { const float s = sc[i * 64 + j];
#pragma unroll
            for (int ee = 0; ee < 16; ++ee) acc[ee] += s * v[j * 128 + e0 + ee]; }
        float s1 = 0.f;
#pragma unroll
        for (int ee = 0; ee < 16; ++ee) s1 += acc[ee];
        s1 += __shfl_xor(s1, 1); s1 += __shfl_xor(s1, 2); s1 += __shfl_xor(s1, 4);
        const float mu = s1 * (1.f / 128.f);
        float s2 = 0.f;
#pragma unroll
        for (int ee = 0; ee < 16; ++ee) { const float dd = acc[ee] - mu; s2 += dd * dd; }
        s2 += __shfl_xor(s2, 1); s2 += __shfl_xor(s2, 2); s2 += __shfl_xor(s2, 4);
        const float rstd = 1.0f / sqrtf(s2 * (1.f / 128.f) + EPS);
        const size_t trow = t0 + i;
#pragma unroll
        for (int ee = 0; ee < 16; ++ee) { const int c = h * 128 + e0 + ee;
            const float g = bf2f(RG[trow * 1024 + c]); const float sg = g / (1.f + expf(-g));
            MIX[trow * DM + c] = (bf16_t)f2bf(sg * (acc[ee] - mu) * rstd * p.ret_gn_g[c]); }
    }
}

__device__ __forceinline__ void phase_attn(const Params& p, unsigned char* ldsb) {
    const int tid = threadIdx.x, wid = tid >> 6, lane = tid & 63;
    float* scw = (float*)ldsb + wid * 4096;
    float* qw = (float*)(ldsb + 8 * 16384) + wid * QKD;
    const bf16_t* MQ = (const bf16_t*)(p.ws + WS_MQ); const bf16_t* MKN = (const bf16_t*)(p.ws + WS_MKN);
    const bf16_t* KR = (const bf16_t*)(p.ws + WS_KR); const bf16_t* MV = (const bf16_t*)(p.ws + WS_MV);
    bf16_t* MIX = (bf16_t*)(p.ws + WS_MIX);
    for (int it = blockIdx.x; it < T; it += gridDim.x) {
        const int t = it, h = wid, b = t / SEQ, s = t % SEQ;
        const int kvlen = (s / CH + 1) * CH;
        const size_t tb = (size_t)b * SEQ;
        for (int d = lane; d < QKD; d += 64) qw[d] = bf2f(d < NOPE ? MQ[(size_t)t * (MH * QKD) + h * NOPE + d] : MQ[(size_t)t * (MH * QKD) + MH * NOPE + h * ROPE + (d - NOPE)]);
        asm volatile("s_waitcnt lgkmcnt(0)" ::: "memory");
        float mx = -1e30f;
        for (int j = lane; j < kvlen; j += 64) {
            const bf16_t* kn = MKN + (tb + j) * 1024 + h * 128; const bf16_t* kr = KR + (tb + j) * 64;
            float dot = 0.f;
#pragma unroll 4
            for (int d = 0; d < 128; d += 8) { const u32x4 w = *(const u32x4*)(kn + d);
                dot += qw[d] * bf2f(w.x & 0xffffu) + qw[d + 1] * bf2f(w.x >> 16) + qw[d + 2] * bf2f(w.y & 0xffffu) + qw[d + 3] * bf2f(w.y >> 16)
                     + qw[d + 4] * bf2f(w.z & 0xffffu) + qw[d + 5] * bf2f(w.z >> 16) + qw[d + 6] * bf2f(w.w & 0xffffu) + qw[d + 7] * bf2f(w.w >> 16); }
#pragma unroll 4
            for (int d = 0; d < 64; d += 8) { const u32x4 w = *(const u32x4*)(kr + d); const float* qq = qw + 128 + d;
                dot += qq[0] * bf2f(w.x & 0xffffu) + qq[1] * bf2f(w.x >> 16) + qq[2] * bf2f(w.y & 0xffffu) + qq[3] * bf2f(w.y >> 16)
                     + qq[4] * bf2f(w.z & 0xffffu) + qq[5] * bf2f(w.z >> 16) + qq[6] * bf2f(w.w & 0xffffu) + qq[7] * bf2f(w.w >> 16); }
            scw[j] = dot; mx = fmaxf(mx, dot);
        }
        mx = wave_max(mx);
        float sum = 0.f;
        for (int j = lane; j < kvlen; j += 64) { const float pe = exp2f(scw[j] - mx); scw[j] = pe; sum += pe; }
        sum = wave_sum(sum);
        asm volatile("s_waitcnt lgkmcnt(0)" ::: "memory");
        float o0 = 0.f, o1 = 0.f;
        const bf16_t* vb = MV + tb * 1024 + h * 128 + 2 * lane;
        for (int j = 0; j < kvlen; ++j) { const unsigned w = *(const unsigned*)(vb + (size_t)j * 1024); const float pj = scw[j];
            o0 += pj * bf2f(w & 0xffffu); o1 += pj * bf2f(w >> 16); }
        const float inv = 1.f / sum;
        *(unsigned*)(MIX + (size_t)t * DM + 1024 + h * 128 + 2 * lane) = pk2(o0 * inv, o1 * inv);
        asm volatile("s_waitcnt lgkmcnt(0)" ::: "memory");
    }
}

__device__ __forceinline__ void phase_ln(float* y, const float* g, const float* bta, bf16_t* yb) {
    const int lane = threadIdx.x & 63, gw = blockIdx.x * 8 + (threadIdx.x >> 6), ngw = gridDim.x * 8;
    for (int row = gw; row < T; row += ngw) {
        f32x4* yr = (f32x4*)(y + (size_t)row * DM) + lane;
        f32x4 v[8]; float s = 0.f;
#pragma unroll
        for (int j = 0; j < 8; ++j) { v[j] = yr[64 * j]; s += (v[j].x + v[j].y) + (v[j].z + v[j].w); }
        const float mean = wave_sum(s) * (1.f / DM); float s2 = 0.f;
#pragma unroll
        for (int j = 0; j < 8; ++j) { v[j] = v[j] - mean; s2 += (v[j].x * v[j].x + v[j].y * v[j].y) + (v[j].z * v[j].z + v[j].w * v[j].w); }
        const float rstd = 1.0f / sqrtf(wave_sum(s2) * (1.f / DM) + EPS);
#pragma unroll
        for (int j = 0; j < 8; ++j) { const int c = 4 * lane + 256 * j; const f32x4 gg = *(const f32x4*)(g + c), bb = *(const f32x4*)(bta + c);
            const f32x4 o = v[j] * rstd * gg + bb; yr[64 * j] = o;
            if (yb) { u32x2 w; w.x = pk2(o.x, o.y); w.y = pk2(o.z, o.w); *(u32x2*)(yb + (size_t)row * DM + c) = w; } }
    }
}

__global__ void __launch_bounds__(NTHREADS, 2) mk_fwd(Params p) {
    extern __shared__ __attribute__((aligned(16))) unsigned char lds[];
    cg::grid_group grid = cg::this_grid();
    unsigned char* ws = p.ws;
#define IN(k) (p.ph_lo <= (k) && (k) < p.ph_hi)
#define SEAM(k) do { if (IN(k) && IN((k) + 1)) grid.sync(); } while (0)
    if (IN(0)) phase_prep(p, lds);
    SEAM(0);
    if (IN(1)) { pg8::Gemm g{(const bf16_t*)(ws + WS_XB), (const bf16_t*)(ws + WS_WIN), T, INWP, DM}; pg8::StaticOrder S; S.init(T, INWP, gridDim.x, blockIdx.x);
        pg8::EpiProj e{ws};
        pg8::gemm_phase<pg8::EpiProj, pg8::StaticOrder, true, true>((PG8_LAS unsigned char*)lds, g, S, e); }
    SEAM(1);
    if (IN(2)) phase_rinv(p);
    SEAM(2);
    if (IN(3)) {
        { pg8::Gemm g{(const bf16_t*)(ws + WS_CQ), (const bf16_t*)(ws + WS_WUQ), T, MH * QKD, QR}; pg8::StaticOrder S; S.init(T, MH * QKD, gridDim.x, blockIdx.x);
          pg8::EpiQ e{(bf16_t*)(ws + WS_MQ), (const float*)(ws + WS_RINVQ), (const float*)(ws + WS_R64)};
          pg8::gemm_phase<pg8::EpiQ, pg8::StaticOrder, true, true>((PG8_LAS unsigned char*)lds, g, S, e); }
        { pg8::Gemm g{(const bf16_t*)(ws + WS_CKV), (const bf16_t*)(ws + WS_WUKV), T, 2048, KVR}; pg8::StaticOrder S; S.init(T, 2048, gridDim.x, blockIdx.x);
          pg8::EpiKV e{ws, (const float*)(ws + WS_RINVKV)};
          pg8::gemm_phase<pg8::EpiKV, pg8::StaticOrder, true, true>((PG8_LAS unsigned char*)lds, g, S, e); }
        __syncthreads();
        phase_ret_kv(p, lds);
    }
    SEAM(3);
    if (IN(4)) { phase_ret_scan(p); phase_attn(p, lds); }
    SEAM(4);
    if (IN(5)) phase_ret_out(p, lds);
    SEAM(5);
    if (IN(6)) { pg8::Gemm g{(const bf16_t*)(ws + WS_MIX), (const bf16_t*)(ws + WS_WOUT), T, DM, DM}; pg8::StaticOrder S; S.init(T, DM, gridDim.x, blockIdx.x);
        pg8::EpiResF32 e{p.x, p.out};
        pg8::gemm_phase<pg8::EpiResF32, pg8::StaticOrder, true, true>((PG8_LAS unsigned char*)lds, g, S, e); }
    SEAM(6);
    if (IN(7)) phase_ln(p.out, p.ln1_g, p.ln1_b, (bf16_t*)(ws + WS_X1B));
    SEAM(7);
    if (IN(8)) { pg8::Gemm g{(const bf16_t*)(ws + WS_X1B), (const bf16_t*)(ws + WS_WUP), T, DFF, DM}; pg8::StaticOrder S; S.init(T, DFF, gridDim.x, blockIdx.x);
        pg8::EpiRelu2 e{(bf16_t*)(ws + WS_HDN)};
        pg8::gemm_phase<pg8::EpiRelu2, pg8::StaticOrder, true, true>((PG8_LAS unsigned char*)lds, g, S, e); }
    SEAM(8);
    if (IN(9)) { pg8::Gemm g{(const bf16_t*)(ws + WS_HDN), (const bf16_t*)(ws + WS_WDN), T, DM, DFF}; pg8::StaticOrder S; S.init(T, DM, gridDim.x, blockIdx.x);
        pg8::EpiResF32 e{p.out, p.out};
        pg8::gemm_phase<pg8::EpiResF32, pg8::StaticOrder, true, true>((PG8_LAS unsigned char*)lds, g, S, e); }
    SEAM(9);
    if (IN(10)) phase_ln(p.out, p.ln2_g, p.ln2_b, nullptr);
#undef IN
#undef SEAM
}

extern "C" void kernel_launch(void* const* d_in, const int* in_sizes, int n_in, void* d_out, int out_size, void* d_ws, size_t ws_size, hipStream_t stream) {
    static int grid = 0;
    if (grid == 0) {
        if (n_in != 16 || in_sizes[0] != T * DM || out_size != T * DM || ws_size < WS_END) {
            fprintf(stderr, "kernel_launch: unexpected shapes n_in %d in0 %d out %d ws %zu\n", n_in, n_in > 0 ? in_sizes[0] : -1, out_size, ws_size); grid = -1; return; }
        int dev = 0, cus = 0, per_cu = 0;
        hipGetDevice(&dev); hipDeviceGetAttribute(&cus, hipDeviceAttributeMultiprocessorCount, dev);
        hipFuncSetAttribute((const void*)mk_fwd, hipFuncAttributeMaxDynamicSharedMemorySize, LDS_BYTES);
        hipOccupancyMaxActiveBlocksPerMultiprocessor(&per_cu, (const void*)mk_fwd, NTHREADS, LDS_BYTES);
        if (per_cu < 1) { fprintf(stderr, "kernel_launch: occupancy query says %d blocks per CU\n", per_cu); per_cu = 1; }
        (void)hipGetLastError();
        grid = cus;
    }
    if (grid < 0) return;
    Params p{};
    p.x = (const float*)d_in[0]; p.pos = (const int*)d_in[1]; p.w_in = (const float*)d_in[2]; p.q_norm_g = (const float*)d_in[3];
    p.w_uq = (const float*)d_in[4]; p.kv_norm_g = (const float*)d_in[5]; p.w_uk = (const float*)d_in[6]; p.w_uv = (const float*)d_in[7];
    p.ret_gn_g = (const float*)d_in[8]; p.w_out = (const float*)d_in[9]; p.ln1_g = (const float*)d_in[10]; p.ln1_b = (const float*)d_in[11];
    p.w_up = (const float*)d_in[12]; p.w_down = (const float*)d_in[13]; p.ln2_g = (const float*)d_in[14]; p.ln2_b = (const float*)d_in[15];
    p.out = (float*)d_out; p.ws = (unsigned char*)d_ws; p.ph_lo = 0; p.ph_hi = 11;
    void* args[] = {&p};
    hipError_t e = hipLaunchCooperativeKernel((const void*)mk_fwd, dim3(grid), dim3(NTHREADS), args, LDS_BYTES, stream);
    if (e != hipSuccess) fprintf(stderr, "cooperative launch failed: %s (grid %d)\n", hipGetErrorString(e), grid);
}
```

```cpp
#include <hip/hip_runtime.h>
#include <hip/hip_cooperative_groups.h>
#include <cstdio>
#include <cstdint>
namespace cg = cooperative_groups;

typedef unsigned short bf16_t;
typedef short bf16x8 __attribute__((ext_vector_type(8)));
typedef float f32x16 __attribute__((ext_vector_type(16)));
typedef float f32x4 __attribute__((ext_vector_type(4)));
typedef unsigned u32x4 __attribute__((ext_vector_type(4)));
typedef unsigned u32x2 __attribute__((ext_vector_type(2)));

constexpr int NB = 4, SEQ = 4096, T = NB * SEQ, DM = 2048;
constexpr int CH = 64, NCH = SEQ / CH;
constexpr int RH = 8, RD = 128;
constexpr int MH = 8, NOPE = 128, ROPE = 64, MDV = 128, QKD = NOPE + ROPE;
constexpr int QR = 768, KVR = 512;
constexpr int INW = 5440, INWP = 5632;
constexpr int DFF = 8192;
constexpr int C_RQ = 0, C_RK = 1024, C_RV = 2048, C_RG = 3072, C_CQ = 4096, C_CKV = 4864, C_KR = 5376;
constexpr float EPS = 1e-5f;
constexpr float ALPHA = 1.189207115002721f;
constexpr float MLA_SCALE_LOG2E = 0.07216878364870322f * 1.4426950408889634f;
constexpr float RK_SCALE = 0.08838834764831845f;

constexpr size_t MiB = 1u << 20;
constexpr size_t WS_WIN = 1 * MiB;
constexpr size_t WS_WUQ = 23 * MiB;
constexpr size_t WS_WUKV = 26 * MiB;
constexpr size_t WS_WOUT = 28 * MiB;
constexpr size_t WS_WUP = 36 * MiB;
constexpr size_t WS_WDN = 68 * MiB;
constexpr size_t WS_R128 = 100 * MiB;
constexpr size_t WS_R64 = 108 * MiB;
constexpr size_t WS_RINVQ = 112 * MiB;
constexpr size_t WS_RINVKV = 112 * MiB + 65536;
constexpr size_t WS_XB = 113 * MiB;
constexpr size_t WS_SP = 113 * MiB;
constexpr size_t WS_RQ = 177 * MiB, WS_RK = 209 * MiB, WS_RV = 241 * MiB, WS_RG = 273 * MiB;
constexpr size_t WS_MQ = 305 * MiB;
constexpr size_t WS_MKN = 353 * MiB;
constexpr size_t WS_KR = 385 * MiB;
constexpr size_t WS_MV = 387 * MiB;
constexpr size_t WS_CQ = 419 * MiB;
constexpr size_t WS_CKV = 443 * MiB;
constexpr size_t WS_MIX = 448 * MiB;
constexpr size_t WS_X1B = 448 * MiB;
constexpr size_t WS_HDN = 113 * MiB;
constexpr size_t WS_END = 512 * MiB;

constexpr int NTHREADS = 512;
constexpr int LDS_BYTES = 147456;

struct Params {
    const float* x; const int* pos; const float* w_in; const float* q_norm_g; const float* w_uq; const float* kv_norm_g;
    const float* w_uk; const float* w_uv; const float* ret_gn_g; const float* w_out; const float* ln1_g; const float* ln1_b;
    const float* w_up; const float* w_down; const float* ln2_g; const float* ln2_b;
    float* out; unsigned char* ws;
    int ph_lo, ph_hi;
};

__device__ __forceinline__ unsigned f2bf(float f) { unsigned u = __float_as_uint(f); return (u + 0x7fffu + ((u >> 16) & 1u)) >> 16; }
__device__ __forceinline__ float bf2f(unsigned v) { return __uint_as_float(v << 16); }
__device__ __forceinline__ unsigned pk2(float lo, float hi) { return f2bf(lo) | (f2bf(hi) << 16); }
__device__ __forceinline__ int crow(int r, int hi) { return (r & 3) + 8 * (r >> 2) + 4 * hi; }
__device__ __forceinline__ float wave_sum(float v) {
#pragma unroll
    for (int o = 1; o < 64; o <<= 1) v += __shfl_xor(v, o);
    return v;
}
__device__ __forceinline__ float wave_max(float v) {
#pragma unroll
    for (int o = 1; o < 64; o <<= 1) v = fmaxf(v, __shfl_xor(v, o));
    return v;
}

__device__ __forceinline__ int d128(int p) { return 64 * ((p >> 2) & 1) + 16 * (p >> 5) + 4 * ((p >> 3) & 3) + (p & 3); }
__device__ __forceinline__ int d64(int p) { return 32 * ((p >> 2) & 1) + 16 * (p >> 5) + 4 * ((p >> 3) & 3) + (p & 3); }
template <int MODE> __device__ __forceinline__ int src_col(int r) {
    if (MODE == 1) {
        if (r < C_RV) return (r & ~127) + d128(r & 127);
        if (r < C_KR) return r;
        if (r < INW) return C_KR + d64(r - C_KR);
        return -1;
    } else if (MODE == 2) {
        if (r < MH * NOPE) return (r >> 7) * QKD + (r & 127);
        const int rr = r - MH * NOPE; return (rr >> 6) * QKD + NOPE + d64(rr & 63);
    }
    return r;
}
template <int MODE>
__device__ __forceinline__ void prep_wt(const float* W, int K, int N, int Npad, bf16_t* Wt, int row_off, const float* kg, float sall, int slo, int shi, float sr, float* lds) {
    const int tid = threadIdx.x;
    const int nkt = K / 64, nnt = Npad / 64;
    for (int it = blockIdx.x; it < nkt * nnt; it += gridDim.x) {
        const int kt = it / nnt, nt = it % nnt, k0 = kt * 64, n0 = nt * 64;
        __syncthreads();
        for (int e = tid; e < 4096; e += NTHREADS) {
            const int kk = e >> 6, nn = e & 63; const int n = n0 + nn; const int sc = src_col<MODE>(n);
            float v = 0.f;
            if (sc >= 0) { v = W[(size_t)(k0 + kk) * N + sc]; if (kg) v *= kg[k0 + kk]; if (n >= slo && n < shi) v *= sr; v *= sall; }
            lds[kk * 65 + nn] = v;
        }
        __syncthreads();
        for (int e = tid; e < 2048; e += NTHREADS) {
            const int nn = e >> 5, kp = (e & 31) * 2;
            const unsigned w = pk2(lds[kp * 65 + nn], lds[(kp + 1) * 65 + nn]);
            *(unsigned*)(Wt + (size_t)(row_off + n0 + nn) * K + k0 + kp) = w;
        }
    }
}
__device__ __forceinline__ void phase_prep(const Params& p, unsigned char* ldsb) {
    float* lds = (float*)ldsb;
    unsigned char* ws = p.ws;
    prep_wt<1>(p.w_in, DM, INW, INWP, (bf16_t*)(ws + WS_WIN), 0, nullptr, 1.f, C_RK, C_RV, RK_SCALE, lds);
    prep_wt<2>(p.w_uq, QR, MH * QKD, MH * QKD, (bf16_t*)(ws + WS_WUQ), 0, p.q_norm_g, MLA_SCALE_LOG2E, 0, 0, 1.f, lds);
    prep_wt<0>(p.w_uk, KVR, MH * NOPE, MH * NOPE, (bf16_t*)(ws + WS_WUKV), 0, p.kv_norm_g, 1.f, 0, 0, 1.f, lds);
    prep_wt<0>(p.w_uv, KVR, MH * MDV, MH * MDV, (bf16_t*)(ws + WS_WUKV), MH * NOPE, p.kv_norm_g, 1.f, 0, 0, 1.f, lds);
    prep_wt<0>(p.w_out, DM, DM, DM, (bf16_t*)(ws + WS_WOUT), 0, nullptr, 1.f, 0, 0, 1.f, lds);
    prep_wt<0>(p.w_up, DM, DFF, DFF, (bf16_t*)(ws + WS_WUP), 0, nullptr, 1.f, 0, 0, 1.f, lds);
    prep_wt<0>(p.w_down, DFF, DM, DM, (bf16_t*)(ws + WS_WDN), 0, nullptr, 1.f, 0, 0, 1.f, lds);
    const size_t gtid = (size_t)blockIdx.x * NTHREADS + threadIdx.x, gsz = (size_t)gridDim.x * NTHREADS;
    bf16_t* xb = (bf16_t*)(ws + WS_XB);
    for (size_t i = gtid; i < (size_t)T * DM / 8; i += gsz) {
        const f32x4 a = *(const f32x4*)(p.x + i * 8), b = *(const f32x4*)(p.x + i * 8 + 4);
        u32x4 w; w.x = pk2(a.x, a.y); w.y = pk2(a.z, a.w); w.z = pk2(b.x, b.y); w.w = pk2(b.z, b.w);
        *(u32x4*)(xb + i * 8) = w;
    }
    float2* r128 = (float2*)(ws + WS_R128); float2* r64 = (float2*)(ws + WS_R64);
    for (size_t i = gtid; i < (size_t)T * 64; i += gsz) {
        const int t = (int)(i >> 6), f = (int)(i & 63);
        const float inv = powf(10000.f, -(float)(2 * f) / 128.f);
        const float ang = (float)p.pos[t] * inv;
        r128[i] = make_float2(cosf(ang), sinf(ang));
    }
    for (size_t i = gtid; i < (size_t)T * 32; i += gsz) {
        const int t = (int)(i >> 5), f = (int)(i & 31);
        const float inv = powf(10000.f, -(float)(2 * f) / 64.f);
        const float ang = (float)p.pos[t] * inv;
        r64[i] = make_float2(cosf(ang), sinf(ang));
    }
}

namespace pg8 {
#define PG8_LAS __attribute__((address_space(3)))
constexpr int BM = 256, BK = 64, HALF = 128, HTB = HALF * BK * 2  , STAGE_BYTES = 8 * HTB, NXCD = 8, WGM = 8;

__host__ __device__ __forceinline__ int lds_byte(int r, int c) { const int st = (r >> 4) * 2 + (c >> 5), rr = r & 15, cc = c & 31, ob = rr * 64 + cc * 2; return st * 1024 + (ob ^ (((ob >> 9) & 1) << 5)); }
__host__ __device__ __forceinline__ void stage_rc(int b, int& R, int& C) { const int st = b / 1024, sb = b % 1024, swz = sb ^ (((sb >> 9) & 1) << 5); R = (st >> 1) * 16 + swz / 64; C = (st & 1) * 32 + (swz % 64) / 2; }
__host__ __device__ __forceinline__ int perm32(int rho) { const int n = rho >> 4, i = rho & 15; return 8 * (i >> 2) + 4 * n + (i & 3); }

struct Unit { int pm, pn; };
struct Gemm { const bf16_t* A; const bf16_t* Bt; int M, N, K; };

struct StaticOrder {
    int nM, nN, nwg, G, c;
    __host__ __device__ void init(int M, int N, int G_, int c_) { nM = M / BM; nN = N / BM; nwg = nM * nN; G = G_; c = c_; }
    __host__ __device__ bool next(int i, Unit& u) const {
        const long L = (long)i * G + c; if (L >= nwg) return false;
        int wgid = (int)L; { const int q = nwg / NXCD, r = nwg % NXCD, xcd = wgid % NXCD, off = wgid / NXCD; wgid = (xcd < r ? xcd * (q + 1) : r * (q + 1) + (xcd - r) * q) + off; }
        const int nig = WGM * nN, gid = wgid / nig, fm = gid * WGM, gsz = (nM - fm) < WGM ? (nM - fm) : WGM;
        u.pm = fm + ((wgid % nig) % gsz); u.pn = (wgid % nig) / gsz; return true;
    }
    __device__ __forceinline__ void a_ready(const Unit&) const {}
    __device__ __forceinline__ void done(const Unit&) const {}
};

__device__ __forceinline__ unsigned cvt_pk_bf16(float lo, float hi) { unsigned r; asm volatile("v_cvt_pk_bf16_f32 %0, %1, %2" : "=v"(r) : "v"(lo), "v"(hi)); return r; }
__device__ __forceinline__ u32x4 pack8(f32x4 v0, f32x4 v1) { u32x4 w; w.x = cvt_pk_bf16(v0[0], v0[1]); w.y = cvt_pk_bf16(v0[2], v0[3]); w.z = cvt_pk_bf16(v1[0], v1[1]); w.w = cvt_pk_bf16(v1[2], v1[3]); return w; }

struct EpiProj {
    static constexpr bool PERM = true, AFTER_DRAIN = false;
    unsigned char* ws;
    __device__ __forceinline__ void operator()(const f32x4 (&acc)[2][2][4][2], const Unit& u, int wr, int wc, int fr, int fq) const {
        const int row0 = u.pm * BM + wr * 64 + fr, pn = u.pn;
        if (pn < 8) {
            const float* r128 = (const float*)(ws + WS_R128);
            bf16_t* dst = (bf16_t*)(ws + (pn < 4 ? WS_RQ : WS_RK)) + (size_t)((pn & 3) * BM + wc * 32 + 8 * fq);
#pragma unroll
            for (int ai = 0; ai < 2; ++ai)
#pragma unroll
                for (int m = 0; m < 4; ++m) { const int row = row0 + ai * HALF + m * 16;
                    const float* tp = r128 + ((size_t)row * 64 + 16 * wc + 4 * fq) * 2; const f32x4 t0 = *(const f32x4*)tp, t1 = *(const f32x4*)(tp + 4);
                    const f32x4 c = {t0[0], t0[2], t1[0], t1[2]}, sn = {t0[1], t0[3], t1[1], t1[3]};
#pragma unroll
                    for (int bj = 0; bj < 2; ++bj) { const f32x4 x1 = acc[ai][bj][m][0], x2 = acc[ai][bj][m][1];
                        *(u32x4*)(dst + (size_t)row * 1024 + bj * HALF) = pack8(x1 * c - x2 * sn, x1 * sn + x2 * c); } }
        } else if (pn < 21) {
            size_t wo; int ld, cb;
            if (pn < 12) { wo = WS_RV; ld = 1024; cb = (pn - 8) * BM; } else if (pn < 16) { wo = WS_RG; ld = 1024; cb = (pn - 12) * BM; }
            else if (pn < 19) { wo = WS_CQ; ld = QR; cb = (pn - 16) * BM; } else { wo = WS_CKV; ld = KVR; cb = (pn - 19) * BM; }
            bf16_t* dst = (bf16_t*)(ws + wo) + cb + wc * 32 + 8 * fq;
#pragma unroll
            for (int ai = 0; ai < 2; ++ai)
#pragma unroll
                for (int m = 0; m < 4; ++m) { const int row = row0 + ai * HALF + m * 16;
#pragma unroll
                    for (int bj = 0; bj < 2; ++bj) *(u32x4*)(dst + (size_t)row * ld + bj * HALF) = pack8(acc[ai][bj][m][0], acc[ai][bj][m][1]); }
        } else if (wc < 2) {
            const float* r64 = (const float*)(ws + WS_R64); bf16_t* kr = (bf16_t*)(ws + WS_KR);
#pragma unroll
            for (int ai = 0; ai < 2; ++ai)
#pragma unroll
                for (int m = 0; m < 4; ++m) { const int row = row0 + ai * HALF + m * 16;
                    const float* tp = r64 + ((size_t)row * 32 + 16 * wc + 4 * fq) * 2; const f32x4 t0 = *(const f32x4*)tp, t1 = *(const f32x4*)(tp + 4);
                    const f32x4 c = {t0[0], t0[2], t1[0], t1[2]}, sn = {t0[1], t0[3], t1[1], t1[3]};
                    const f32x4 x1 = acc[ai][0][m][0], x2 = acc[ai][0][m][1];
                    *(u32x4*)(kr + (size_t)row * 64 + wc * 32 + 8 * fq) = pack8(x1 * c - x2 * sn, x1 * sn + x2 * c); }
        }
    }
};
struct EpiQ {
    static constexpr bool PERM = true, AFTER_DRAIN = false;
    bf16_t* mq; const float* rinv; const float* r64;
    __device__ __forceinline__ void operator()(const f32x4 (&acc)[2][2][4][2], const Unit& u, int wr, int wc, int fr, int fq) const {
        const int row0 = u.pm * BM + wr * 64 + fr, pn = u.pn;
        bf16_t* dst = mq + (size_t)(pn * BM + wc * 32 + 8 * fq);
#pragma unroll
        for (int ai = 0; ai < 2; ++ai)
#pragma unroll
            for (int m = 0; m < 4; ++m) { const int row = row0 + ai * HALF + m * 16; const float s = rinv[row];
                if (pn < 4) {
#pragma unroll
                    for (int bj = 0; bj < 2; ++bj) *(u32x4*)(dst + (size_t)row * (MH * QKD) + bj * HALF) = pack8(acc[ai][bj][m][0] * s, acc[ai][bj][m][1] * s);
                } else {
                    const float* tp = r64 + ((size_t)row * 32 + 16 * (wc & 1) + 4 * fq) * 2; const f32x4 t0 = *(const f32x4*)tp, t1 = *(const f32x4*)(tp + 4);
                    const f32x4 c = {t0[0], t0[2], t1[0], t1[2]}, sn = {t0[1], t0[3], t1[1], t1[3]};
#pragma unroll
                    for (int bj = 0; bj < 2; ++bj) { const f32x4 x1 = acc[ai][bj][m][0] * s, x2 = acc[ai][bj][m][1] * s;
                        *(u32x4*)(dst + (size_t)row * (MH * QKD) + bj * HALF) = pack8(x1 * c - x2 * sn, x1 * sn + x2 * c); }
                } }
    }
};
struct EpiKV {
    static constexpr bool PERM = true, AFTER_DRAIN = false;
    unsigned char* ws; const float* rinv;
    __device__ __forceinline__ void operator()(const f32x4 (&acc)[2][2][4][2], const Unit& u, int wr, int wc, int fr, int fq) const {
        const int row0 = u.pm * BM + wr * 64 + fr, pn = u.pn;
        bf16_t* dst = (bf16_t*)(ws + (pn < 4 ? WS_MKN : WS_MV)) + (size_t)((pn & 3) * BM + wc * 32 + 8 * fq);
#pragma unroll
        for (int ai = 0; ai < 2; ++ai)
#pragma unroll
            for (int m = 0; m < 4; ++m) { const int row = row0 + ai * HALF + m * 16; const float s = rinv[row];
#pragma unroll
                for (int bj = 0; bj < 2; ++bj) *(u32x4*)(dst + (size_t)row * 1024 + bj * HALF) = pack8(acc[ai][bj][m][0] * s, acc[ai][bj][m][1] * s); }
    }
};
struct EpiResF32 {
    static constexpr bool PERM = false, AFTER_DRAIN = false;
    const float* base; float* y;
    __device__ __forceinline__ void operator()(const f32x4 (&acc)[2][2][4][2], const Unit& u, int wr, int wc, int fr, int fq) const {
        const int row0 = u.pm * BM + wr * 64 + fr, col0 = u.pn * BM + wc * 32 + 4 * fq;
#pragma unroll
        for (int ai = 0; ai < 2; ++ai)
#pragma unroll
            for (int m = 0; m < 4; ++m) { const size_t off = (size_t)(row0 + ai * HALF + m * 16) * DM + col0;
#pragma unroll
                for (int bj = 0; bj < 2; ++bj)
#pragma unroll
                    for (int n = 0; n < 2; ++n) { const f32x4 b = *(const f32x4*)(base + off + bj * HALF + n * 16); *(f32x4*)(y + off + bj * HALF + n * 16) = b * ALPHA + acc[ai][bj][m][n]; } }
    }
};
struct EpiRelu2 {
    static constexpr bool PERM = true, AFTER_DRAIN = false;
    bf16_t* h;
    __device__ __forceinline__ void operator()(const f32x4 (&acc)[2][2][4][2], const Unit& u, int wr, int wc, int fr, int fq) const {
        const int row0 = u.pm * BM + wr * 64 + fr;
        bf16_t* dst = h + (size_t)(u.pn * BM + wc * 32 + 8 * fq);
        const f32x4 z = {0.f, 0.f, 0.f, 0.f};
#pragma unroll
        for (int ai = 0; ai < 2; ++ai)
#pragma unroll
            for (int m = 0; m < 4; ++m) { const int row = row0 + ai * HALF + m * 16;
#pragma unroll
                for (int bj = 0; bj < 2; ++bj) { const f32x4 a = __builtin_elementwise_max(acc[ai][bj][m][0], z), b = __builtin_elementwise_max(acc[ai][bj][m][1], z);
                    *(u32x4*)(dst + (size_t)row * DFF + bj * HALF) = pack8(a * a, b * b); } }
    }
};

template <class Epi, class Sched, bool ALIGN_EPI = false, bool SP2 = false>
__device__ __forceinline__ void gemm_phase(PG8_LAS unsigned char* lds, const Gemm g, const Sched& S, const Epi& E) {
    const int tid = threadIdx.x, wid = __builtin_amdgcn_readfirstlane(tid >> 6), lane = tid & 63, wr = wid >> 2, wc = wid & 3, fr = lane & 15, fq = lane >> 4;
    const int K = g.K, nt = K / BK;
    unsigned voffA[2], voffB[2];
#pragma unroll
    for (int i = 0; i < 2; ++i) { int R, C; stage_rc(tid * 16 + i * 8192, R, C); const int Rb = Epi::PERM ? ((R & ~31) + perm32(R & 31)) : R;
        voffA[i] = (unsigned)(R * K + C) * 2u; voffB[i] = (unsigned)(Rb * K + C) * 2u; }
    const size_t kstep = (size_t)(BK * 2);
    const size_t hstep = (size_t)HALF * K * 2;
    const size_t tstep = 2 * hstep;
    const unsigned ldsw = (unsigned)wid * 1024u;
    const int aoff = lds_byte(wr * 64 + fr, fq * 8), boff = lds_byte(wc * 32 + fr, fq * 8);
#define PG8_SA(b, h) (((b) * 2 + (h)) * HTB)
#define PG8_SB(b, h) ((4 + (b) * 2 + (h)) * HTB)
#define PG8_STAGE(bufoff, gbase, voff) do { _Pragma("unroll") for (int _i = 0; _i < 2; ++_i) \
        __builtin_amdgcn_global_load_lds((const unsigned*)((const char*)(gbase) + (voff)[_i]), (PG8_LAS unsigned*)(lds + (bufoff) + ldsw + _i * 8192), 16, 0, 0); } while (0)
#define PG8_LDA(dst, b, h) do { _Pragma("unroll") for (int m = 0; m < 4; ++m) _Pragma("unroll") for (int k = 0; k < 2; ++k) dst[m][k] = *(const PG8_LAS bf16x8*)(lds + PG8_SA(b, h) + aoff + m * 2048 + k * 1024); } while (0)
#define PG8_LDB(dst, b, h) do { _Pragma("unroll") for (int n = 0; n < 2; ++n) _Pragma("unroll") for (int k = 0; k < 2; ++k) dst[n][k] = *(const PG8_LAS bf16x8*)(lds + PG8_SB(b, h) + boff + n * 2048 + k * 1024); } while (0)
#define PG8_MMA(ai, bj, At, Bt) do { __builtin_amdgcn_s_setprio(1); _Pragma("unroll") for (int m = 0; m < 4; ++m) _Pragma("unroll") for (int n = 0; n < 2; ++n) _Pragma("unroll") for (int k = 0; k < 2; ++k) \
        acc[ai][bj][m][n] = __builtin_amdgcn_mfma_f32_16x16x32_bf16(Bt[n][k], At[m][k], acc[ai][bj][m][n], 0, 0, 0); __builtin_amdgcn_s_setprio(0); } while (0)
#define PG8_WAIT_V(n) asm volatile("s_waitcnt vmcnt(" #n ")" ::: "memory")
#define PG8_WAIT_L(n) asm volatile("s_waitcnt lgkmcnt(" #n ")" ::: "memory")
#define PG8_BAR __builtin_amdgcn_s_barrier()
#define PG8_SCHED __builtin_amdgcn_sched_barrier(0)
    Unit cur, nxt; int ui = 0;
    if (!S.next(0, cur)) return;
    f32x4 acc[2][2][4][2];
#pragma unroll
    for (int a = 0; a < 2; ++a)
#pragma unroll
        for (int b = 0; b < 2; ++b)
#pragma unroll
            for (int m = 0; m < 4; ++m)
#pragma unroll
                for (int n = 0; n < 2; ++n) acc[a][b][m][n] = (f32x4){0.f, 0.f, 0.f, 0.f};
    bf16x8 At[4][2], B0[2][2], B1[2][2];
    const char* cA = (const char*)g.A + (size_t)cur.pm * tstep; const char* cB = (const char*)g.Bt + (size_t)cur.pn * tstep;
    S.a_ready(cur);
    if constexpr (SP2) {
        PG8_STAGE(PG8_SB(0, 0), cB, voffB); PG8_STAGE(PG8_SB(0, 1), cB + hstep, voffB); PG8_STAGE(PG8_SA(0, 0), cA, voffA); PG8_STAGE(PG8_SA(0, 1), cA + hstep, voffA);
        if (wr == 1) PG8_BAR;
        PG8_WAIT_V(2); PG8_BAR;
        PG8_STAGE(PG8_SB(1, 0), cB + kstep, voffB); PG8_STAGE(PG8_SA(1, 0), cA + kstep, voffA); PG8_STAGE(PG8_SB(1, 1), cB + hstep + kstep, voffB);
        PG8_WAIT_V(6); PG8_BAR;
    } else {
        PG8_STAGE(PG8_SB(0, 0), cB, voffB); PG8_STAGE(PG8_SA(0, 0), cA, voffA); PG8_STAGE(PG8_SB(0, 1), cB + hstep, voffB); PG8_STAGE(PG8_SA(0, 1), cA + hstep, voffA);
        if (wr == 1) PG8_BAR;
        PG8_WAIT_V(4); PG8_BAR;
        PG8_STAGE(PG8_SB(1, 0), cB + kstep, voffB); PG8_STAGE(PG8_SA(1, 0), cA + kstep, voffA); PG8_STAGE(PG8_SB(1, 1), cB + hstep + kstep, voffB);
        PG8_WAIT_V(6); PG8_BAR;
    }
    for (;;) {
        const bool has_next = S.next(ui + 1, nxt);
        const char* nA = has_next ? (const char*)g.A + (size_t)nxt.pm * tstep : cA; const char* nB = has_next ? (const char*)g.Bt + (size_t)nxt.pn * tstep : cB;
        for (int t = 0; t < nt; t += 2) {
            const bool last = (t == nt - 2);
            const char* a1 = cA + (size_t)(t + 1) * kstep;
            const char* a2 = last ? nA : cA + (size_t)(t + 2) * kstep; const char* b2 = last ? nB : cB + (size_t)(t + 2) * kstep;
            const char* a3 = a2 + kstep; const char* b3 = b2 + kstep;
            if (last && has_next) S.a_ready(nxt);
            if constexpr (SP2) {
            PG8_LDB(B0, 0, 0); PG8_LDB(B1, 0, 1); PG8_SCHED; PG8_LDA(At, 0, 0); PG8_STAGE(PG8_SA(1, 1), a1 + hstep, voffA);
            PG8_WAIT_V(8); PG8_WAIT_L(0); PG8_BAR; PG8_MMA(0, 0, At, B0); PG8_MMA(0, 1, At, B1); PG8_BAR; PG8_SCHED;
            PG8_LDA(At, 0, 1); PG8_STAGE(PG8_SB(0, 0), b2, voffB); PG8_STAGE(PG8_SB(0, 1), b2 + hstep, voffB); PG8_STAGE(PG8_SA(0, 0), a2, voffA);
            PG8_WAIT_V(8); PG8_WAIT_L(0); PG8_BAR; PG8_MMA(1, 0, At, B0); PG8_MMA(1, 1, At, B1); PG8_BAR; PG8_SCHED;
            PG8_LDB(B0, 1, 0); PG8_LDB(B1, 1, 1); PG8_SCHED; PG8_LDA(At, 1, 0); PG8_STAGE(PG8_SA(0, 1), a2 + hstep, voffA);
            PG8_WAIT_V(8); PG8_WAIT_L(0); PG8_BAR; PG8_MMA(0, 0, At, B0); PG8_MMA(0, 1, At, B1); PG8_BAR; PG8_SCHED;
            PG8_LDA(At, 1, 1); PG8_STAGE(PG8_SB(1, 0), b3, voffB); PG8_STAGE(PG8_SB(1, 1), b3 + hstep, voffB); PG8_STAGE(PG8_SA(1, 0), a3, voffA);
            PG8_WAIT_V(8); PG8_WAIT_L(0); PG8_BAR; PG8_MMA(1, 0, At, B0); PG8_MMA(1, 1, At, B1); PG8_BAR; PG8_SCHED;
            } else {
            PG8_LDB(B0, 0, 0); PG8_SCHED; PG8_LDA(At, 0, 0); PG8_STAGE(PG8_SA(1, 1), a1 + hstep, voffA);
            PG8_WAIT_L(8); PG8_BAR; PG8_WAIT_L(0); PG8_MMA(0, 0, At, B0); PG8_BAR; PG8_SCHED;
            PG8_LDB(B1, 0, 1); PG8_STAGE(PG8_SB(0, 0), b2, voffB);
            PG8_BAR; PG8_WAIT_L(0); PG8_MMA(0, 1, At, B1); PG8_BAR;
            PG8_LDA(At, 0, 1); PG8_STAGE(PG8_SA(0, 0), a2, voffA);
            PG8_BAR; PG8_WAIT_L(0); PG8_MMA(1, 0, At, B0); PG8_BAR; PG8_SCHED;
            PG8_STAGE(PG8_SB(0, 1), b2 + hstep, voffB);
            PG8_WAIT_V(6); PG8_BAR; PG8_MMA(1, 1, At, B1); PG8_BAR;
            PG8_LDB(B0, 1, 0); PG8_SCHED; PG8_LDA(At, 1, 0); PG8_STAGE(PG8_SA(0, 1), a2 + hstep, voffA);
            PG8_WAIT_L(8); PG8_BAR; PG8_WAIT_L(0); PG8_MMA(0, 0, At, B0); PG8_BAR; PG8_SCHED;
            PG8_LDB(B1, 1, 1); PG8_STAGE(PG8_SB(1, 0), b3, voffB);
            PG8_BAR; PG8_WAIT_L(0); PG8_MMA(0, 1, At, B1); PG8_BAR;
            PG8_LDA(At, 1, 1); PG8_STAGE(PG8_SA(1, 0), a3, voffA);
            PG8_BAR; PG8_WAIT_L(0); PG8_MMA(1, 0, At, B0); PG8_BAR; PG8_SCHED;
            PG8_STAGE(PG8_SB(1, 1), b3 + hstep, voffB);
            PG8_WAIT_V(6); PG8_BAR; PG8_MMA(1, 1, At, B1); PG8_BAR;
            }
        }
        if constexpr (ALIGN_EPI) { if (wr == 0) PG8_BAR; }
        if constexpr (!Epi::AFTER_DRAIN) { E(acc, cur, wr, wc, fr, fq); S.done(cur); }
        if (!has_next) break;
#pragma unroll
        for (int a = 0; a < 2; ++a)
#pragma unroll
            for (int b = 0; b < 2; ++b)
#pragma unroll
                for (int m = 0; m < 4; ++m)
#pragma unroll
                    for (int n = 0; n < 2; ++n) acc[a][b][m][n] = (f32x4){0.f, 0.f, 0.f, 0.f};
        cur = nxt; cA = nA; cB = nB; ++ui;
        if constexpr (ALIGN_EPI) { if (wr == 1) PG8_BAR; }
    }
    PG8_WAIT_V(0);
    if constexpr (!ALIGN_EPI) { if (wr == 0) PG8_BAR; }
    PG8_BAR;
    if constexpr (Epi::AFTER_DRAIN) { E.fused(acc, cur, wr, wc, fr, fq, lds, wid, lane); S.done(cur); }
#undef PG8_SA
#undef PG8_SB
#undef PG8_STAGE
#undef PG8_LDA
#undef PG8_LDB
#undef PG8_MMA
#undef PG8_WAIT_V
#undef PG8_WAIT_L
#undef PG8_BAR
#undef PG8_SCHED
}
}

__device__ __forceinline__ void phase_rinv(const Params& p) {
    const int lane = threadIdx.x & 63, gw = blockIdx.x * 8 + (threadIdx.x >> 6), ngw = gridDim.x * 8;
    const bf16_t* cq = (const bf16_t*)(p.ws + WS_CQ); const bf16_t* ckv = (const bf16_t*)(p.ws + WS_CKV);
    float* rq = (float*)(p.ws + WS_RINVQ); float* rkv = (float*)(p.ws + WS_RINVKV);
    for (int row = gw; row < T; row += ngw) {
        float s = 0.f;
        for (int c = lane; c < QR; c += 64) { const float v = bf2f(cq[(size_t)row * QR + c]); s += v * v; }
        s = wave_sum(s);
        float s2 = 0.f;
        for (int c = lane; c < KVR; c += 64) { const float v = bf2f(ckv[(size_t)row * KVR + c]); s2 += v * v; }
        s2 = wave_sum(s2);
        if (lane == 0) { rq[row] = 1.0f / sqrtf(s / (float)QR + EPS); rkv[row] = 1.0f / sqrtf(s2 / (float)KVR + EPS); }
    }
}

__device__ __forceinline__ float ret_logg(int h) { return log1pf(-exp2f(-5.0f - (float)h)); }
__device__ __forceinline__ void phase_ret_kv(const Params& p, unsigned char* ldsb) {
    float* kd = (float*)ldsb;
    float* vv = kd + 64 * 128;
    const bf16_t* RK = (const bf16_t*)(p.ws + WS_RK); const bf16_t* RV = (const bf16_t*)(p.ws + WS_RV);
    float* KVS = p.out;
    const int tid = threadIdx.x;
    for (int it = blockIdx.x; it < NB * RH * NCH; it += gridDim.x) {
        const int bh = it / NCH, n = it % NCH, b = bh / RH, h = bh % RH;
        const float lg = ret_logg(h);
        const size_t t0 = (size_t)b * SEQ + (size_t)n * CH;
        __syncthreads();
        for (int e = tid; e < 64 * 128; e += NTHREADS) { const int j = e >> 7, d = e & 127;
            kd[e] = bf2f(RK[(t0 + j) * 1024 + h * 128 + d]) * expf(lg * (float)(63 - j));
            vv[e] = bf2f(RV[(t0 + j) * 1024 + h * 128 + d]); }
        __syncthreads();
        const int d = tid >> 2, eg = tid & 3;
        float acc[32];
#pragma unroll
        for (int i = 0; i < 32; ++i) acc[i] = 0.f;
        for (int j = 0; j < 64; ++j) { const float kv = kd[j * 128 + d];
#pragma unroll
            for (int i = 0; i < 32; ++i) acc[i] += kv * vv[j * 128 + eg * 32 + i]; }
        float* dst = KVS + ((size_t)it * 128 + d) * 128 + eg * 32;
#pragma unroll
        for (int i = 0; i < 32; i += 4) *(f32x4*)(dst + i) = (f32x4){acc[i], acc[i + 1], acc[i + 2], acc[i + 3]};
    }
}
__device__ __forceinline__ void phase_ret_scan(const Params& p) {
    const float* KVS = p.out; bf16_t* SP = (bf16_t*)(p.ws + WS_SP);
    const size_t gtid = (size_t)blockIdx.x * NTHREADS + threadIdx.x, gsz = (size_t)gridDim.x * NTHREADS;
    for (size_t i = gtid; i < (size_t)NB * RH * 128 * 128; i += gsz) {
        const int bh = (int)(i >> 14), d = (int)((i >> 7) & 127), e = (int)(i & 127), h = bh % RH;
        const float cd = expf(ret_logg(h) * 64.f);
        float S = 0.f;
        for (int n = 0; n < NCH; ++n) {
            SP[(((size_t)bh * NCH + n) * 128 + e) * 128 + d] = (bf16_t)f2bf(S);
            S = cd * S + KVS[(((size_t)bh * NCH + n) * 128 + d) * 128 + e];
        }
    }
}
__device__ __forceinline__ void phase_ret_out(const Params& p, unsigned char* ldsb) {
    float* q = (float*)ldsb;
    float* k = q + 64 * 128;
    float* v = k + 64 * 129;
    float* sc = v + 64 * 128;
    const bf16_t* RQ = (const bf16_t*)(p.ws + WS_RQ); const bf16_t* RK = (const bf16_t*)(p.ws + WS_RK);
    const bf16_t* RV = (const bf16_t*)(p.ws + WS_RV); const bf16_t* RG = (const bf16_t*)(p.ws + WS_RG);
    const bf16_t* SP = (const bf16_t*)(p.ws + WS_SP); bf16_t* MIX = (bf16_t*)(p.ws + WS_MIX);
    const int tid = threadIdx.x;
    for (int it = blockIdx.x; it < NB * RH * NCH; it += gridDim.x) {
        const int bh = it / NCH, n = it % NCH, b = bh / RH, h = bh % RH;
        const float lg = ret_logg(h);
        const size_t t0 = (size_t)b * SEQ + (size_t)n * CH;
        __syncthreads();
        for (int e = tid; e < 64 * 128; e += NTHREADS) { const int j = e >> 7, d = e & 127; const size_t g = (t0 + j) * 1024 + h * 128 + d;
            q[e] = bf2f(RQ[g]); k[j * 129 + d] = bf2f(RK[g]); v[e] = bf2f(RV[g]); }
        __syncthreads();
        { const int i = tid >> 3, j0 = (tid & 7) * 8;
#pragma unroll 1
          for (int jj = 0; jj < 8; ++jj) { const int j = j0 + jj; float s = 0.f;
#pragma unroll 4
              for (int d = 0; d < 128; ++d) s += q[i * 128 + d] * k[j * 129 + d];
              const int dist = i > j ? i - j : j - i;
              sc[i * 64 + j] = s * expf(lg * (float)dist); } }
        __syncthreads();
        const int i = tid >> 3, e0 = (tid & 7) * 16;
        float acc[16];
#pragma unroll
        for (int ee = 0; ee < 16; ++ee) acc[ee] = 0.f;
        const bf16_t* sp = SP + ((size_t)it * 128 + e0) * 128;
#pragma unroll 1
        for (int d = 0; d < 128; d += 8) {
            float qv[8];
#pragma unroll
            for (int x = 0; x < 8; ++x) qv[x] = q[i * 128 + d + x];
#pragma unroll
            for (int ee = 0; ee < 16; ++ee) { const u32x4 w = *(const u32x4*)(sp + (size_t)ee * 128 + d);
                acc[ee] += qv[0] * bf2f(w.x & 0xffffu) + qv[1] * bf2f(w.x >> 16) + qv[2] * bf2f(w.y & 0xffffu) + qv[3] * bf2f(w.y >> 16)
                         + qv[4] * bf2f(w.z & 0xffffu) + qv[5] * bf2f(w.z >> 16) + qv[6] * bf2f(w.w & 0xffffu) + qv[7] * bf2f(w.w >> 16); }
        }
        const float qdec = expf(lg * (float)(i + 1));
#pragma unroll
        for (int ee = 0; ee < 16; ++ee) acc[ee] *= qdec;
#pragma unroll 2
        for (int j = 0; j < 64; ++j) { const float s = sc[i * 64 + j];
#pragma unroll
            for (int ee = 0; ee < 16; ++ee) acc[ee] += s * v[j * 128 + e0 + ee]; }
        float s1 = 0.f;
#pragma unroll
        for (int ee = 0; ee < 16; ++ee) s1 += acc[ee];
        s1 += __shfl_xor(s1, 1); s1 += __shfl_xor(s1, 2); s1 += __shfl_xor(s1, 4);
        const float mu = s1 * (1.f / 128.f);
        float s2 = 0.f;
#pragma unroll
        for (int ee = 0; ee < 16; ++ee) { const float dd = acc[ee] - mu; s2 += dd * dd; }
        s2 += __shfl_xor(s2, 1); s2 += __shfl_xor(s2, 2); s2 += __shfl_xor(s2, 4);
        const float rstd = 1.0f / sqrtf(s2 * (1.f / 128.f) + EPS);
        const size_t trow = t0 + i;
#pragma unroll
        for (int ee = 0; ee < 16; ++ee) { const int c = h * 128 + e0 + ee;
            const float g = bf2f(RG[trow * 1024 + c]); const float sg = g / (1.f + expf(-g));
            MIX[trow * DM + c] = (bf16_t)f2bf(sg * (acc[ee] - mu) * rstd * p.ret_gn_g[c]); }
    }
}

namespace attn {
typedef __attribute__((address_space(3))) unsigned char* lptr;
typedef short s16x4 __attribute__((ext_vector_type(4)));
constexpr int KN_OFF = 0, KR_OFF = 16384, V_OFF = 24576, BUF = 40960, SCR_OFF = 2 * BUF, LDS_NEED = SCR_OFF + 8 * 256;
constexpr float THR = 8.f;

__device__ __forceinline__ int v_rd_base(int lane) { return ((lane & 3) << 3) | (((lane >> 2) & 3) << 6) | (((lane >> 4) & 1) << 5) | (((lane >> 5) & 1) << 8); }
constexpr int v_rd_off(int d0, int ks, int half) { return d0 * 512 + ks * 4096 + half * 2048; }
__device__ __forceinline__ unsigned cvtpk(float lo, float hi) { unsigned r; asm volatile("v_cvt_pk_bf16_f32 %0, %1, %2" : "=v"(r) : "v"(lo), "v"(hi)); return r; }
__device__ __forceinline__ s16x4 vtr(lptr p) { return __builtin_bit_cast(s16x4, __builtin_amdgcn_ds_read_tr16_b64_v4i16((__attribute__((address_space(3))) s16x4*)p)); }
__device__ __forceinline__ void dma16(const void* g, lptr l) { __builtin_amdgcn_global_load_lds((const unsigned*)g, (__attribute__((address_space(3))) unsigned*)l, 16, 0, 0); }

struct Src { unsigned kn[2], kr, v[2]; };
__device__ __forceinline__ Src make_src(int wid, int lane) {
    Src s;
#pragma unroll
    for (int i = 0; i < 2; ++i) { const int pi = wid + 8 * i;
        { const int row = 4 * pi + (lane >> 4), colB = ((lane & 15) << 4) ^ ((row & 7) << 4); s.kn[i] = (unsigned)(row * 1024 + colB / 2); }
        { const int sub = 2 * pi + (lane >> 5), kk = (sub >> 2) * 8 + ((lane & 31) >> 2), key = (kk & ~0xC) | ((kk & 4) << 1) | ((kk & 8) >> 1), col = (sub & 3) * 32 + (lane & 3) * 8;
          s.v[i] = (unsigned)(key * 1024 + col); } }
    { const int row = 8 * wid + (lane >> 3), chunk = (lane & 7) ^ ((row >> 1) & 7); s.kr = (unsigned)(row * 64 + chunk * 8); }
    return s;
}

__device__ __forceinline__ void attn_unit(lptr lds, const bf16_t* MQ, const bf16_t* MKN, const bf16_t* KR, const bf16_t* MV, bf16_t* MIX, int b, int h, int qb) {
    const int tid = threadIdx.x, wid = __builtin_amdgcn_readfirstlane(tid >> 6), lane = tid & 63, r32 = lane & 31, hi = lane >> 5;
    const int NT = 4 * qb + 4, cw = 4 * qb + (wid >> 1);
    const size_t tb = (size_t)b * SEQ;
    const Src src = make_src(wid, lane);
    const bf16_t* knb = MKN + tb * 1024 + h * 128; const bf16_t* krb = KR + tb * 64; const bf16_t* vb = MV + tb * 1024 + h * 128;
#define ATT_STAGE(t, buf) do { const size_t ro_ = (size_t)(t) * 64; lptr lb_ = lds + (buf) * BUF + wid * 1024; \
        dma16(knb + ro_ * 1024 + src.kn[0], lb_ + KN_OFF); dma16(knb + ro_ * 1024 + src.kn[1], lb_ + KN_OFF + 8192); \
        dma16(krb + ro_ * 64 + src.kr, lb_ + KR_OFF); \
        dma16(vb + ro_ * 1024 + src.v[0], lb_ + V_OFF); dma16(vb + ro_ * 1024 + src.v[1], lb_ + V_OFF + 8192); } while (0)
    ATT_STAGE(0, 0);
    const size_t qrow = tb + (size_t)qb * 256 + wid * 32 + r32;
    bf16x8 qr[12];
#pragma unroll
    for (int d0 = 0; d0 < 8; ++d0) qr[d0] = *(const bf16x8*)(MQ + qrow * (MH * QKD) + h * NOPE + d0 * 16 + hi * 8);
#pragma unroll
    for (int d0 = 0; d0 < 4; ++d0) qr[8 + d0] = *(const bf16x8*)(MQ + qrow * (MH * QKD) + MH * NOPE + h * ROPE + d0 * 16 + hi * 8);
    float m_reg = -1e30f, l_reg = 0.f;
    f32x16 o[4];
#pragma unroll
    for (int d = 0; d < 4; ++d)
#pragma unroll
        for (int r = 0; r < 16; ++r) o[d][r] = 0.f;
    __attribute__((address_space(3))) float* scr = (__attribute__((address_space(3))) float*)(lds + SCR_OFF + wid * 256);
    int kno[4], kro[4];
#pragma unroll
    for (int dd = 0; dd < 4; ++dd) { kno[dd] = r32 * 256 + (((dd * 16 + hi * 8) * 2) ^ ((r32 & 7) << 4)); kro[dd] = r32 * 128 + 16 * ((2 * dd + hi) ^ ((r32 >> 1) & 7)); }
    const int vro = v_rd_base(lane);
    asm volatile("s_waitcnt vmcnt(0)" ::: "memory"); __builtin_amdgcn_s_barrier(); asm volatile("" ::: "memory");
    for (int t = 0; t < NT; ++t) {
        const int cur = t & 1;
        if (t + 1 < NT) ATT_STAGE(t + 1, cur ^ 1);
        if (t <= cw) {
            lptr kn = lds + cur * BUF + KN_OFF, kr = lds + cur * BUF + KR_OFF, vv = lds + cur * BUF + V_OFF + vro;
            f32x16 p0, p1;
#pragma unroll
            for (int r = 0; r < 16; ++r) { p0[r] = 0.f; p1[r] = 0.f; }
#pragma unroll
            for (int d0 = 0; d0 < 8; ++d0) { lptr a = kn + kno[d0 & 3] + (d0 >> 2) * 128;
                const bf16x8 b0 = *(const __attribute__((address_space(3))) bf16x8*)a, b1 = *(const __attribute__((address_space(3))) bf16x8*)(a + 32 * 256);
                p0 = __builtin_amdgcn_mfma_f32_32x32x16_bf16(b0, qr[d0], p0, 0, 0, 0); p1 = __builtin_amdgcn_mfma_f32_32x32x16_bf16(b1, qr[d0], p1, 0, 0, 0); }
#pragma unroll
            for (int d0 = 0; d0 < 4; ++d0) { lptr a = kr + kro[d0];
                const bf16x8 b0 = *(const __attribute__((address_space(3))) bf16x8*)a, b1 = *(const __attribute__((address_space(3))) bf16x8*)(a + 32 * 128);
                p0 = __builtin_amdgcn_mfma_f32_32x32x16_bf16(b0, qr[8 + d0], p0, 0, 0, 0); p1 = __builtin_amdgcn_mfma_f32_32x32x16_bf16(b1, qr[8 + d0], p1, 0, 0, 0); }
            float pmax = p0[0];
#pragma unroll
            for (int r = 1; r < 16; ++r) pmax = fmaxf(pmax, p0[r]);
#pragma unroll
            for (int r = 0; r < 16; ++r) pmax = fmaxf(pmax, p1[r]);
            { auto rr = __builtin_amdgcn_permlane32_swap(__float_as_uint(pmax), __float_as_uint(pmax), false, false); pmax = fmaxf(__uint_as_float(rr[0]), __uint_as_float(rr[1])); }
            float mn, alpha;
            if (__all(pmax - m_reg <= THR)) { mn = m_reg; alpha = 1.f; }
            else { mn = fmaxf(m_reg, pmax); alpha = __builtin_amdgcn_exp2f(m_reg - mn); m_reg = mn; }
#pragma unroll
            for (int r = 0; r < 16; ++r) { p0[r] = __builtin_amdgcn_exp2f(p0[r] - mn); p1[r] = __builtin_amdgcn_exp2f(p1[r] - mn); }
            float ps = 0.f;
#pragma unroll
            for (int r = 0; r < 16; ++r) ps += p0[r] + p1[r];
            { auto rr = __builtin_amdgcn_permlane32_swap(__float_as_uint(ps), __float_as_uint(ps), false, false); ps = __uint_as_float(rr[0]) + __uint_as_float(rr[1]); }
            l_reg = l_reg * alpha + ps;
            bf16x8 pa0, pa1, pa2, pa3;
#define ATT_PK4(P, B_, OUT) do { unsigned a0 = cvtpk(P[B_ + 0], P[B_ + 1]), a1 = cvtpk(P[B_ + 2], P[B_ + 3]); unsigned b0 = cvtpk(P[B_ + 4], P[B_ + 5]), b1 = cvtpk(P[B_ + 6], P[B_ + 7]); \
        auto r0 = __builtin_amdgcn_permlane32_swap(a0, b0, false, false); auto r1 = __builtin_amdgcn_permlane32_swap(a1, b1, false, false); \
        u32x4 w = {r0[0], r1[0], r0[1], r1[1]}; OUT = __builtin_bit_cast(bf16x8, w); } while (0)
            ATT_PK4(p0, 0, pa0); ATT_PK4(p0, 8, pa1); ATT_PK4(p1, 0, pa2); ATT_PK4(p1, 8, pa3);
#undef ATT_PK4
            if (__any(alpha < 1.f)) { if (hi == 0) scr[r32] = alpha; asm volatile("s_waitcnt lgkmcnt(0)" ::: "memory");
#pragma unroll
                for (int r = 0; r < 16; ++r) { const float a = scr[crow(r, hi)];
#pragma unroll
                    for (int d = 0; d < 4; ++d) o[d][r] *= a; } }
#pragma unroll
            for (int d0 = 0; d0 < 4; ++d0) {
                s16x4 lo[4], hh[4];
#pragma unroll
                for (int ks = 0; ks < 4; ++ks) { lo[ks] = vtr(vv + v_rd_off(d0, ks, 0)); hh[ks] = vtr(vv + v_rd_off(d0, ks, 1)); }
#define ATT_VF(k) (bf16x8){lo[k][0], lo[k][1], lo[k][2], lo[k][3], hh[k][0], hh[k][1], hh[k][2], hh[k][3]}
                o[d0] = __builtin_amdgcn_mfma_f32_32x32x16_bf16(pa0, ATT_VF(0), o[d0], 0, 0, 0);
                o[d0] = __builtin_amdgcn_mfma_f32_32x32x16_bf16(pa1, ATT_VF(1), o[d0], 0, 0, 0);
                o[d0] = __builtin_amdgcn_mfma_f32_32x32x16_bf16(pa2, ATT_VF(2), o[d0], 0, 0, 0);
                o[d0] = __builtin_amdgcn_mfma_f32_32x32x16_bf16(pa3, ATT_VF(3), o[d0], 0, 0, 0);
#undef ATT_VF
            }
        }
        asm volatile("s_waitcnt vmcnt(0) lgkmcnt(0)" ::: "memory"); __builtin_amdgcn_s_barrier(); asm volatile("" ::: "memory");
    }
#undef ATT_STAGE
    if (hi == 0) scr[32 + r32] = l_reg;
    asm volatile("s_waitcnt lgkmcnt(0)" ::: "memory");
    bf16_t* Ow = MIX + (tb + (size_t)qb * 256 + wid * 32) * DM + 1024 + h * 128;
#pragma unroll
    for (int r = 0; r < 16; ++r) { const int orow = crow(r, hi); const float rl = __builtin_amdgcn_rcpf(scr[32 + orow]);
#pragma unroll
        for (int d0 = 0; d0 < 4; ++d0) { const float v = o[d0][r] * rl; const float vn = __shfl_xor(v, 1);
            if ((r32 & 1) == 0) *(unsigned*)(Ow + (size_t)orow * DM + d0 * 32 + r32) = cvtpk(v, vn); } }
    asm volatile("s_waitcnt lgkmcnt(0)" ::: "memory");
}

__device__ __forceinline__ void attn_phase(lptr lds, const bf16_t* MQ, const bf16_t* MKN, const bf16_t* KR, const bf16_t* MV, bf16_t* MIX) {
    const int G = gridDim.x, bx = blockIdx.x, vcu = (G % 8 == 0) ? (bx % 8) * (G / 8) + bx / 8 : bx;
    for (int u = vcu; u < NB * MH * 8; u += G) {
        const int bh = u >> 3, s = u & 7;
        attn_unit(lds, MQ, MKN, KR, MV, MIX, bh / MH, bh % MH, 15 - s);
        attn_unit(lds, MQ, MKN, KR, MV, MIX, bh / MH, bh % MH, s);
    }
}
}

__device__ __forceinline__ void phase_ln(float* y, const float* g, const float* bta, bf16_t* yb) {
    const int lane = threadIdx.x & 63, gw = blockIdx.x * 8 + (threadIdx.x >> 6), ngw = gridDim.x * 8;
    for (int row = gw; row < T; row += ngw) {
        f32x4* yr = (f32x4*)(y + (size_t)row * DM) + lane;
        f32x4 v[8]; float s = 0.f;
#pragma unroll
        for (int j = 0; j < 8; ++j) { v[j] = yr[64 * j]; s += (v[j].x + v[j].y) + (v[j].z + v[j].w); }
        const float mean = wave_sum(s) * (1.f / DM); float s2 = 0.f;
#pragma unroll
        for (int j = 0; j < 8; ++j) { v[j] = v[j] - mean; s2 += (v[j].x * v[j].x + v[j].y * v[j].y) + (v[j].z * v[j].z + v[j].w * v[j].w); }
        const float rstd = 1.0f / sqrtf(wave_sum(s2) * (1.f / DM) + EPS);
#pragma unroll
        for (int j = 0; j < 8; ++j) { const int c = 4 * lane + 256 * j; const f32x4 gg = *(const f32x4*)(g + c), bb = *(const f32x4*)(bta + c);
            const f32x4 o = v[j] * rstd * gg + bb; yr[64 * j] = o;
            if (yb) { u32x2 w; w.x = pk2(o.x, o.y); w.y = pk2(o.z, o.w); *(u32x2*)(yb + (size_t)row * DM + c) = w; } }
    }
}

__global__ void __launch_bounds__(NTHREADS, 2) mk_fwd(Params p) {
    extern __shared__ __attribute__((aligned(16))) unsigned char lds[];
    cg::grid_group grid = cg::this_grid();
    unsigned char* ws = p.ws;
#define IN(k) (p.ph_lo <= (k) && (k) < p.ph_hi)
#define SEAM(k) do { if (IN(k) && IN((k) + 1)) grid.sync(); } while (0)
    if (IN(0)) phase_prep(p, lds);
    SEAM(0);
    if (IN(1)) { pg8::Gemm g{(const bf16_t*)(ws + WS_XB), (const bf16_t*)(ws + WS_WIN), T, INWP, DM}; pg8::StaticOrder S; S.init(T, INWP, gridDim.x, blockIdx.x);
        pg8::EpiProj e{ws};
        pg8::gemm_phase<pg8::EpiProj, pg8::StaticOrder, true, true>((PG8_LAS unsigned char*)lds, g, S, e); }
    SEAM(1);
    if (IN(2)) phase_rinv(p);
    SEAM(2);
    if (IN(3)) {
        { pg8::Gemm g{(const bf16_t*)(ws + WS_CQ), (const bf16_t*)(ws + WS_WUQ), T, MH * QKD, QR}; pg8::StaticOrder S; S.init(T, MH * QKD, gridDim.x, blockIdx.x);
          pg8::EpiQ e{(bf16_t*)(ws + WS_MQ), (const float*)(ws + WS_RINVQ), (const float*)(ws + WS_R64)};
          pg8::gemm_phase<pg8::EpiQ, pg8::StaticOrder, true, true>((PG8_LAS unsigned char*)lds, g, S, e); }
        { pg8::Gemm g{(const bf16_t*)(ws + WS_CKV), (const bf16_t*)(ws + WS_WUKV), T, 2048, KVR}; pg8::StaticOrder S; S.init(T, 2048, gridDim.x, blockIdx.x);
          pg8::EpiKV e{ws, (const float*)(ws + WS_RINVKV)};
          pg8::gemm_phase<pg8::EpiKV, pg8::StaticOrder, true, true>((PG8_LAS unsigned char*)lds, g, S, e); }
        __syncthreads();
        phase_ret_kv(p, lds);
    }
    SEAM(3);
    if (IN(4)) { phase_ret_scan(p);
        attn::attn_phase((attn::lptr)lds, (const bf16_t*)(ws + WS_MQ), (const bf16_t*)(ws + WS_MKN), (const bf16_t*)(ws + WS_KR), (const bf16_t*)(ws + WS_MV), (bf16_t*)(ws + WS_MIX)); }
    SEAM(4);
    if (IN(5)) phase_ret_out(p, lds);
    SEAM(5);
    if (IN(6)) { pg8::Gemm g{(const bf16_t*)(ws + WS_MIX), (const bf16_t*)(ws + WS_WOUT), T, DM, DM}; pg8::StaticOrder S; S.init(T, DM, gridDim.x, blockIdx.x);
        pg8::EpiResF32 e{p.x, p.out};
        pg8::gemm_phase<pg8::EpiResF32, pg8::StaticOrder, true, true>((PG8_LAS unsigned char*)lds, g, S, e); }
    SEAM(6);
    if (IN(7)) phase_ln(p.out, p.ln1_g, p.ln1_b, (bf16_t*)(ws + WS_X1B));
    SEAM(7);
    if (IN(8)) { pg8::Gemm g{(const bf16_t*)(ws + WS_X1B), (const bf16_t*)(ws + WS_WUP), T, DFF, DM}; pg8::StaticOrder S; S.init(T, DFF, gridDim.x, blockIdx.x);
        pg8::EpiRelu2 e{(bf16_t*)(ws + WS_HDN)};
        pg8::gemm_phase<pg8::EpiRelu2, pg8::StaticOrder, true, true>((PG8_LAS unsigned char*)lds, g, S, e); }
    SEAM(8);
    if (IN(9)) { pg8::Gemm g{(const bf16_t*)(ws + WS_HDN), (const bf16_t*)(ws + WS_WDN), T, DM, DFF}; pg8::StaticOrder S; S.init(T, DM, gridDim.x, blockIdx.x);
        pg8::EpiResF32 e{p.out, p.out};
        pg8::gemm_phase<pg8::EpiResF32, pg8::StaticOrder, true, true>((PG8_LAS unsigned char*)lds, g, S, e); }
    SEAM(9);
    if (IN(10)) phase_ln(p.out, p.ln2_g, p.ln2_b, nullptr);
#undef IN
#undef SEAM
}

extern "C" void kernel_launch(void* const* d_in, const int* in_sizes, int n_in, void* d_out, int out_size, void* d_ws, size_t ws_size, hipStream_t stream) {
    static int grid = 0;
    if (grid == 0) {
        if (n_in != 16 || in_sizes[0] != T * DM || out_size != T * DM || ws_size < WS_END) {
            fprintf(stderr, "kernel_launch: unexpected shapes n_in %d in0 %d out %d ws %zu\n", n_in, n_in > 0 ? in_sizes[0] : -1, out_size, ws_size); grid = -1; return; }
        int dev = 0, cus = 0, per_cu = 0;
        hipGetDevice(&dev); hipDeviceGetAttribute(&cus, hipDeviceAttributeMultiprocessorCount, dev);
        hipFuncSetAttribute((const void*)mk_fwd, hipFuncAttributeMaxDynamicSharedMemorySize, LDS_BYTES);
        hipOccupancyMaxActiveBlocksPerMultiprocessor(&per_cu, (const void*)mk_fwd, NTHREADS, LDS_BYTES);
        if (per_cu < 1) { fprintf(stderr, "kernel_launch: occupancy query says %d blocks per CU\n", per_cu); per_cu = 1; }
        (void)hipGetLastError();
        grid = cus;
    }
    if (grid < 0) return;
    Params p{};
    p.x = (const float*)d_in[0]; p.pos = (const int*)d_in[1]; p.w_in = (const float*)d_in[2]; p.q_norm_g = (const float*)d_in[3];
    p.w_uq = (const float*)d_in[4]; p.kv_norm_g = (const float*)d_in[5]; p.w_uk = (const float*)d_in[6]; p.w_uv = (const float*)d_in[7];
    p.ret_gn_g = (const float*)d_in[8]; p.w_out = (const float*)d_in[9]; p.ln1_g = (const float*)d_in[10]; p.ln1_b = (const float*)d_in[11];
    p.w_up = (const float*)d_in[12]; p.w_down = (const float*)d_in[13]; p.ln2_g = (const float*)d_in[14]; p.ln2_b = (const float*)d_in[15];
    p.out = (float*)d_out; p.ws = (unsigned char*)d_ws; p.ph_lo = 0; p.ph_hi = 11;
    void* args[] = {&p};
    hipError_t e = hipLaunchCooperativeKernel((const void*)mk_fwd, dim3(grid), dim3(NTHREADS), args, LDS_BYTES, stream);
    if (e != hipSuccess) fprintf(stderr, "cooperative launch failed: %s (grid %d)\n", hipGetErrorString(e), grid);
}
```

```cpp
#include <hip/hip_runtime.h>
#include <hip/hip_cooperative_groups.h>
#include <cstdio>
#include <cstdint>
namespace cg = cooperative_groups;

typedef unsigned short bf16_t;
typedef short bf16x8 __attribute__((ext_vector_type(8)));
typedef float f32x16 __attribute__((ext_vector_type(16)));
typedef float f32x4 __attribute__((ext_vector_type(4)));
typedef unsigned u32x4 __attribute__((ext_vector_type(4)));
typedef unsigned u32x2 __attribute__((ext_vector_type(2)));

constexpr int NB = 4, SEQ = 4096, T = NB * SEQ, DM = 2048;
constexpr int CH = 64, NCH = SEQ / CH;
constexpr int RH = 8, RD = 128;
constexpr int MH = 8, NOPE = 128, ROPE = 64, MDV = 128, QKD = NOPE + ROPE;
constexpr int QR = 768, KVR = 512;
constexpr int INW = 5440, INWP = 5632;
constexpr int DFF = 8192;
constexpr int C_RQ = 0, C_RK = 1024, C_RV = 2048, C_RG = 3072, C_CQ = 4096, C_CKV = 4864, C_KR = 5376;
constexpr float EPS = 1e-5f;
constexpr float ALPHA = 1.189207115002721f;
constexpr float MLA_SCALE_LOG2E = 0.07216878364870322f * 1.4426950408889634f;
constexpr float RK_SCALE = 0.08838834764831845f;

constexpr size_t MiB = 1u << 20;
constexpr size_t WS_WIN = 1 * MiB;
constexpr size_t WS_WUQ = 23 * MiB;
constexpr size_t WS_WUKV = 26 * MiB;
constexpr size_t WS_WOUT = 28 * MiB;
constexpr size_t WS_WUP = 36 * MiB;
constexpr size_t WS_WDN = 68 * MiB;
constexpr size_t WS_R128 = 100 * MiB;
constexpr size_t WS_R64 = 108 * MiB;
constexpr size_t WS_RINVQ = 112 * MiB;
constexpr size_t WS_RINVKV = 112 * MiB + 65536;
constexpr size_t WS_XB = 113 * MiB;
constexpr size_t WS_SP = 113 * MiB;
constexpr size_t WS_RQ = 177 * MiB, WS_RK = 209 * MiB, WS_RV = 241 * MiB, WS_RG = 273 * MiB;
constexpr size_t WS_MQ = 305 * MiB;
constexpr size_t WS_MKN = 353 * MiB;
constexpr size_t WS_KR = 385 * MiB;
constexpr size_t WS_MV = 387 * MiB;
constexpr size_t WS_CQ = 419 * MiB;
constexpr size_t WS_CKV = 443 * MiB;
constexpr size_t WS_MIX = 448 * MiB;
constexpr size_t WS_X1B = 448 * MiB;
constexpr size_t WS_HDN = 113 * MiB;
constexpr size_t WS_END = 512 * MiB;

constexpr int NTHREADS = 512;
constexpr int LDS_BYTES = 147456;

struct Params {
    const float* x; const int* pos; const float* w_in; const float* q_norm_g; const float* w_uq; const float* kv_norm_g;
    const float* w_uk; const float* w_uv; const float* ret_gn_g; const float* w_out; const float* ln1_g; const float* ln1_b;
    const float* w_up; const float* w_down; const float* ln2_g; const float* ln2_b;
    float* out; unsigned char* ws;
    int ph_lo, ph_hi;
};

__device__ __forceinline__ unsigned f2bf(float f) { unsigned u = __float_as_uint(f); return (u + 0x7fffu + ((u >> 16) & 1u)) >> 16; }
__device__ __forceinline__ float bf2f(unsigned v) { return __uint_as_float(v << 16); }
__device__ __forceinline__ unsigned pk2(float lo, float hi) { return f2bf(lo) | (f2bf(hi) << 16); }
__device__ __forceinline__ int crow(int r, int hi) { return (r & 3) + 8 * (r >> 2) + 4 * hi; }
__device__ __forceinline__ float wave_sum(float v) {
#pragma unroll
    for (int o = 1; o < 64; o <<= 1) v += __shfl_xor(v, o);
    return v;
}
__device__ __forceinline__ float wave_max(float v) {
#pragma unroll
    for (int o = 1; o < 64; o <<= 1) v = fmaxf(v, __shfl_xor(v, o));
    return v;
}

__device__ __forceinline__ int d128(int p) { return 64 * ((p >> 2) & 1) + 16 * (p >> 5) + 4 * ((p >> 3) & 3) + (p & 3); }
__device__ __forceinline__ int d64(int p) { return 32 * ((p >> 2) & 1) + 16 * (p >> 5) + 4 * ((p >> 3) & 3) + (p & 3); }
template <int MODE> __device__ __forceinline__ int src_col(int r) {
    if (MODE == 1) {
        if (r < C_RV) return (r & ~127) + d128(r & 127);
        if (r < C_KR) return r;
        if (r < INW) return C_KR + d64(r - C_KR);
        return -1;
    } else if (MODE == 2) {
        if (r < MH * NOPE) return (r >> 7) * QKD + (r & 127);
        const int rr = r - MH * NOPE; return (rr >> 6) * QKD + NOPE + d64(rr & 63);
    }
    return r;
}
template <int MODE>
__device__ __forceinline__ void prep_wt(const float* W, int K, int N, int Npad, bf16_t* Wt, int row_off, const float* kg, float sall, int slo, int shi, float sr, float* lds) {
    const int tid = threadIdx.x;
    const int nkt = K / 64, nnt = Npad / 64;
    for (int it = blockIdx.x; it < nkt * nnt; it += gridDim.x) {
        const int kt = it / nnt, nt = it % nnt, k0 = kt * 64, n0 = nt * 64;
        __syncthreads();
        for (int e = tid; e < 4096; e += NTHREADS) {
            const int kk = e >> 6, nn = e & 63; const int n = n0 + nn; const int sc = src_col<MODE>(n);
            float v = 0.f;
            if (sc >= 0) { v = W[(size_t)(k0 + kk) * N + sc]; if (kg) v *= kg[k0 + kk]; if (n >= slo && n < shi) v *= sr; v *= sall; }
            lds[kk * 65 + nn] = v;
        }
        __syncthreads();
        for (int e = tid; e < 2048; e += NTHREADS) {
            const int nn = e >> 5, kp = (e & 31) * 2;
            const unsigned w = pk2(lds[kp * 65 + nn], lds[(kp + 1) * 65 + nn]);
            *(unsigned*)(Wt + (size_t)(row_off + n0 + nn) * K + k0 + kp) = w;
        }
    }
}
__device__ __forceinline__ void phase_prep(const Params& p, unsigned char* ldsb) {
    float* lds = (float*)ldsb;
    unsigned char* ws = p.ws;
    prep_wt<1>(p.w_in, DM, INW, INWP, (bf16_t*)(ws + WS_WIN), 0, nullptr, 1.f, C_RK, C_RV, RK_SCALE, lds);
    prep_wt<2>(p.w_uq, QR, MH * QKD, MH * QKD, (bf16_t*)(ws + WS_WUQ), 0, p.q_norm_g, MLA_SCALE_LOG2E, 0, 0, 1.f, lds);
    prep_wt<0>(p.w_uk, KVR, MH * NOPE, MH * NOPE, (bf16_t*)(ws + WS_WUKV), 0, p.kv_norm_g, 1.f, 0, 0, 1.f, lds);
    prep_wt<0>(p.w_uv, KVR, MH * MDV, MH * MDV, (bf16_t*)(ws + WS_WUKV), MH * NOPE, p.kv_norm_g, 1.f, 0, 0, 1.f, lds);
    prep_wt<0>(p.w_out, DM, DM, DM, (bf16_t*)(ws + WS_WOUT), 0, nullptr, 1.f, 0, 0, 1.f, lds);
    prep_wt<0>(p.w_up, DM, DFF, DFF, (bf16_t*)(ws + WS_WUP), 0, nullptr, 1.f, 0, 0, 1.f, lds);
    prep_wt<0>(p.w_down, DFF, DM, DM, (bf16_t*)(ws + WS_WDN), 0, nullptr, 1.f, 0, 0, 1.f, lds);
    const size_t gtid = (size_t)blockIdx.x * NTHREADS + threadIdx.x, gsz = (size_t)gridDim.x * NTHREADS;
    bf16_t* xb = (bf16_t*)(ws + WS_XB);
    for (size_t i = gtid; i < (size_t)T * DM / 8; i += gsz) {
        const f32x4 a = *(const f32x4*)(p.x + i * 8), b = *(const f32x4*)(p.x + i * 8 + 4);
        u32x4 w; w.x = pk2(a.x, a.y); w.y = pk2(a.z, a.w); w.z = pk2(b.x, b.y); w.w = pk2(b.z, b.w);
        *(u32x4*)(xb + i * 8) = w;
    }
    float2* r128 = (float2*)(ws + WS_R128); float2* r64 = (float2*)(ws + WS_R64);
    for (size_t i = gtid; i < (size_t)T * 64; i += gsz) {
        const int t = (int)(i >> 6), f = (int)(i & 63);
        const float inv = powf(10000.f, -(float)(2 * f) / 128.f);
        const float ang = (float)p.pos[t] * inv;
        r128[i] = make_float2(cosf(ang), sinf(ang));
    }
    for (size_t i = gtid; i < (size_t)T * 32; i += gsz) {
        const int t = (int)(i >> 5), f = (int)(i & 31);
        const float inv = powf(10000.f, -(float)(2 * f) / 64.f);
        const float ang = (float)p.pos[t] * inv;
        r64[i] = make_float2(cosf(ang), sinf(ang));
    }
}

namespace pg8 {
#define PG8_LAS __attribute__((address_space(3)))
constexpr int BM = 256, BK = 64, HALF = 128, HTB = HALF * BK * 2  , STAGE_BYTES = 8 * HTB, NXCD = 8, WGM = 8;

__host__ __device__ __forceinline__ int lds_byte(int r, int c) { const int st = (r >> 4) * 2 + (c >> 5), rr = r & 15, cc = c & 31, ob = rr * 64 + cc * 2; return st * 1024 + (ob ^ (((ob >> 9) & 1) << 5)); }
__host__ __device__ __forceinline__ void stage_rc(int b, int& R, int& C) { const int st = b / 1024, sb = b % 1024, swz = sb ^ (((sb >> 9) & 1) << 5); R = (st >> 1) * 16 + swz / 64; C = (st & 1) * 32 + (swz % 64) / 2; }
__host__ __device__ __forceinline__ int perm32(int rho) { const int n = rho >> 4, i = rho & 15; return 8 * (i >> 2) + 4 * n + (i & 3); }

struct Unit { int pm, pn; };
struct Gemm { const bf16_t* A; const bf16_t* Bt; int M, N, K; };

struct StaticOrder {
    int nM, nN, nwg, G, c;
    __host__ __device__ void init(int M, int N, int G_, int c_) { nM = M / BM; nN = N / BM; nwg = nM * nN; G = G_; c = c_; }
    __host__ __device__ bool next(int i, Unit& u) const {
        const long L = (long)i * G + c; if (L >= nwg) return false;
        int wgid = (int)L; { const int q = nwg / NXCD, r = nwg % NXCD, xcd = wgid % NXCD, off = wgid / NXCD; wgid = (xcd < r ? xcd * (q + 1) : r * (q + 1) + (xcd - r) * q) + off; }
        const int nig = WGM * nN, gid = wgid / nig, fm = gid * WGM, gsz = (nM - fm) < WGM ? (nM - fm) : WGM;
        u.pm = fm + ((wgid % nig) % gsz); u.pn = (wgid % nig) / gsz; return true;
    }
    __device__ __forceinline__ void a_ready(const Unit&) const {}
    __device__ __forceinline__ void done(const Unit&) const {}
};

__device__ __forceinline__ unsigned cvt_pk_bf16(float lo, float hi) { unsigned r; asm volatile("v_cvt_pk_bf16_f32 %0, %1, %2" : "=v"(r) : "v"(lo), "v"(hi)); return r; }
__device__ __forceinline__ u32x4 pack8(f32x4 v0, f32x4 v1) { u32x4 w; w.x = cvt_pk_bf16(v0[0], v0[1]); w.y = cvt_pk_bf16(v0[2], v0[3]); w.z = cvt_pk_bf16(v1[0], v1[1]); w.w = cvt_pk_bf16(v1[2], v1[3]); return w; }

struct EpiProj {
    static constexpr bool PERM = true, AFTER_DRAIN = false;
    unsigned char* ws;
    __device__ __forceinline__ void operator()(const f32x4 (&acc)[2][2][4][2], const Unit& u, int wr, int wc, int fr, int fq) const {
        const int row0 = u.pm * BM + wr * 64 + fr, pn = u.pn;
        if (pn < 8) {
            const float* r128 = (const float*)(ws + WS_R128);
            bf16_t* dst = (bf16_t*)(ws + (pn < 4 ? WS_RQ : WS_RK)) + (size_t)((pn & 3) * BM + wc * 32 + 8 * fq);
#pragma unroll
            for (int ai = 0; ai < 2; ++ai)
#pragma unroll
                for (int m = 0; m < 4; ++m) { const int row = row0 + ai * HALF + m * 16;
                    const float* tp = r128 + ((size_t)row * 64 + 16 * wc + 4 * fq) * 2; const f32x4 t0 = *(const f32x4*)tp, t1 = *(const f32x4*)(tp + 4);
                    const f32x4 c = {t0[0], t0[2], t1[0], t1[2]}, sn = {t0[1], t0[3], t1[1], t1[3]};
#pragma unroll
                    for (int bj = 0; bj < 2; ++bj) { const f32x4 x1 = acc[ai][bj][m][0], x2 = acc[ai][bj][m][1];
                        *(u32x4*)(dst + (size_t)row * 1024 + bj * HALF) = pack8(x1 * c - x2 * sn, x1 * sn + x2 * c); } }
        } else if (pn < 21) {
            size_t wo; int ld, cb;
            if (pn < 12) { wo = WS_RV; ld = 1024; cb = (pn - 8) * BM; } else if (pn < 16) { wo = WS_RG; ld = 1024; cb = (pn - 12) * BM; }
            else if (pn < 19) { wo = WS_CQ; ld = QR; cb = (pn - 16) * BM; } else { wo = WS_CKV; ld = KVR; cb = (pn - 19) * BM; }
            bf16_t* dst = (bf16_t*)(ws + wo) + cb + wc * 32 + 8 * fq;
#pragma unroll
            for (int ai = 0; ai < 2; ++ai)
#pragma unroll
                for (int m = 0; m < 4; ++m) { const int row = row0 + ai * HALF + m * 16;
#pragma unroll
                    for (int bj = 0; bj < 2; ++bj) *(u32x4*)(dst + (size_t)row * ld + bj * HALF) = pack8(acc[ai][bj][m][0], acc[ai][bj][m][1]); }
        } else if (wc < 2) {
            const float* r64 = (const float*)(ws + WS_R64); bf16_t* kr = (bf16_t*)(ws + WS_KR);
#pragma unroll
            for (int ai = 0; ai < 2; ++ai)
#pragma unroll
                for (int m = 0; m < 4; ++m) { const int row = row0 + ai * HALF + m * 16;
                    const float* tp = r64 + ((size_t)row * 32 + 16 * wc + 4 * fq) * 2; const f32x4 t0 = *(const f32x4*)tp, t1 = *(const f32x4*)(tp + 4);
                    const f32x4 c = {t0[0], t0[2], t1[0], t1[2]}, sn = {t0[1], t0[3], t1[1], t1[3]};
                    const f32x4 x1 = acc[ai][0][m][0], x2 = acc[ai][0][m][1];
                    *(u32x4*)(kr + (size_t)row * 64 + wc * 32 + 8 * fq) = pack8(x1 * c - x2 * sn, x1 * sn + x2 * c); }
        }
    }
};
struct EpiQ {
    static constexpr bool PERM = true, AFTER_DRAIN = false;
    bf16_t* mq; const float* rinv; const float* r64;
    __device__ __forceinline__ void operator()(const f32x4 (&acc)[2][2][4][2], const Unit& u, int wr, int wc, int fr, int fq) const {
        const int row0 = u.pm * BM + wr * 64 + fr, pn = u.pn;
        bf16_t* dst = mq + (size_t)(pn * BM + wc * 32 + 8 * fq);
#pragma unroll
        for (int ai = 0; ai < 2; ++ai)
#pragma unroll
            for (int m = 0; m < 4; ++m) { const int row = row0 + ai * HALF + m * 16; const float s = rinv[row];
                if (pn < 4) {
#pragma unroll
                    for (int bj = 0; bj < 2; ++bj) *(u32x4*)(dst + (size_t)row * (MH * QKD) + bj * HALF) = pack8(acc[ai][bj][m][0] * s, acc[ai][bj][m][1] * s);
                } else {
                    const float* tp = r64 + ((size_t)row * 32 + 16 * (wc & 1) + 4 * fq) * 2; const f32x4 t0 = *(const f32x4*)tp, t1 = *(const f32x4*)(tp + 4);
                    const f32x4 c = {t0[0], t0[2], t1[0], t1[2]}, sn = {t0[1], t0[3], t1[1], t1[3]};
#pragma unroll
                    for (int bj = 0; bj < 2; ++bj) { const f32x4 x1 = acc[ai][bj][m][0] * s, x2 = acc[ai][bj][m][1] * s;
                        *(u32x4*)(dst + (size_t)row * (MH * QKD) + bj * HALF) = pack8(x1 * c - x2 * sn, x1 * sn + x2 * c); }
                } }
    }
};
struct EpiKV {
    static constexpr bool PERM = true, AFTER_DRAIN = false;
    unsigned char* ws; const float* rinv;
    __device__ __forceinline__ void operator()(const f32x4 (&acc)[2][2][4][2], const Unit& u, int wr, int wc, int fr, int fq) const {
        const int row0 = u.pm * BM + wr * 64 + fr, pn = u.pn;
        bf16_t* dst = (bf16_t*)(ws + (pn < 4 ? WS_MKN : WS_MV)) + (size_t)((pn & 3) * BM + wc * 32 + 8 * fq);
#pragma unroll
        for (int ai = 0; ai < 2; ++ai)
#pragma unroll
            for (int m = 0; m < 4; ++m) { const int row = row0 + ai * HALF + m * 16; const float s = rinv[row];
#pragma unroll
                for (int bj = 0; bj < 2; ++bj) *(u32x4*)(dst + (size_t)row * 1024 + bj * HALF) = pack8(acc[ai][bj][m][0] * s, acc[ai][bj][m][1] * s); }
    }
};
struct EpiResF32 {
    static constexpr bool PERM = false, AFTER_DRAIN = false;
    const float* base; float* y;
    __device__ __forceinline__ void operator()(const f32x4 (&acc)[2][2][4][2], const Unit& u, int wr, int wc, int fr, int fq) const {
        const int row0 = u.pm * BM + wr * 64 + fr, col0 = u.pn * BM + wc * 32 + 4 * fq;
#pragma unroll
        for (int ai = 0; ai < 2; ++ai)
#pragma unroll
            for (int m = 0; m < 4; ++m) { const size_t off = (size_t)(row0 + ai * HALF + m * 16) * DM + col0;
#pragma unroll
                for (int bj = 0; bj < 2; ++bj)
#pragma unroll
                    for (int n = 0; n < 2; ++n) { const f32x4 b = *(const f32x4*)(base + off + bj * HALF + n * 16); *(f32x4*)(y + off + bj * HALF + n * 16) = b * ALPHA + acc[ai][bj][m][n]; } }
    }
};
struct EpiRelu2 {
    static constexpr bool PERM = true, AFTER_DRAIN = false;
    bf16_t* h;
    __device__ __forceinline__ void operator()(const f32x4 (&acc)[2][2][4][2], const Unit& u, int wr, int wc, int fr, int fq) const {
        const int row0 = u.pm * BM + wr * 64 + fr;
        bf16_t* dst = h + (size_t)(u.pn * BM + wc * 32 + 8 * fq);
        const f32x4 z = {0.f, 0.f, 0.f, 0.f};
#pragma unroll
        for (int ai = 0; ai < 2; ++ai)
#pragma unroll
            for (int m = 0; m < 4; ++m) { const int row = row0 + ai * HALF + m * 16;
#pragma unroll
                for (int bj = 0; bj < 2; ++bj) { const f32x4 a = __builtin_elementwise_max(acc[ai][bj][m][0], z), b = __builtin_elementwise_max(acc[ai][bj][m][1], z);
                    *(u32x4*)(dst + (size_t)row * DFF + bj * HALF) = pack8(a * a, b * b); } }
    }
};

template <class Epi, class Sched, bool ALIGN_EPI = false, bool SP2 = false>
__device__ __forceinline__ void gemm_phase(PG8_LAS unsigned char* lds, const Gemm g, const Sched& S, const Epi& E) {
    const int tid = threadIdx.x, wid = __builtin_amdgcn_readfirstlane(tid >> 6), lane = tid & 63, wr = wid >> 2, wc = wid & 3, fr = lane & 15, fq = lane >> 4;
    const int K = g.K, nt = K / BK;
    unsigned voffA[2], voffB[2];
#pragma unroll
    for (int i = 0; i < 2; ++i) { int R, C; stage_rc(tid * 16 + i * 8192, R, C); const int Rb = Epi::PERM ? ((R & ~31) + perm32(R & 31)) : R;
        voffA[i] = (unsigned)(R * K + C) * 2u; voffB[i] = (unsigned)(Rb * K + C) * 2u; }
    const size_t kstep = (size_t)(BK * 2);
    const size_t hstep = (size_t)HALF * K * 2;
    const size_t tstep = 2 * hstep;
    const unsigned ldsw = (unsigned)wid * 1024u;
    const int aoff = lds_byte(wr * 64 + fr, fq * 8), boff = lds_byte(wc * 32 + fr, fq * 8);
#define PG8_SA(b, h) (((b) * 2 + (h)) * HTB)
#define PG8_SB(b, h) ((4 + (b) * 2 + (h)) * HTB)
#define PG8_STAGE(bufoff, gbase, voff) do { _Pragma("unroll") for (int _i = 0; _i < 2; ++_i) \
        __builtin_amdgcn_global_load_lds((const unsigned*)((const char*)(gbase) + (voff)[_i]), (PG8_LAS unsigned*)(lds + (bufoff) + ldsw + _i * 8192), 16, 0, 0); } while (0)
#define PG8_LDA(dst, b, h) do { _Pragma("unroll") for (int m = 0; m < 4; ++m) _Pragma("unroll") for (int k = 0; k < 2; ++k) dst[m][k] = *(const PG8_LAS bf16x8*)(lds + PG8_SA(b, h) + aoff + m * 2048 + k * 1024); } while (0)
#define PG8_LDB(dst, b, h) do { _Pragma("unroll") for (int n = 0; n < 2; ++n) _Pragma("unroll") for (int k = 0; k < 2; ++k) dst[n][k] = *(const PG8_LAS bf16x8*)(lds + PG8_SB(b, h) + boff + n * 2048 + k * 1024); } while (0)
#define PG8_MMA(ai, bj, At, Bt) do { __builtin_amdgcn_s_setprio(1); _Pragma("unroll") for (int m = 0; m < 4; ++m) _Pragma("unroll") for (int n = 0; n < 2; ++n) _Pragma("unroll") for (int k = 0; k < 2; ++k) \
        acc[ai][bj][m][n] = __builtin_amdgcn_mfma_f32_16x16x32_bf16(Bt[n][k], At[m][k], acc[ai][bj][m][n], 0, 0, 0); __builtin_amdgcn_s_setprio(0); } while (0)
#define PG8_WAIT_V(n) asm volatile("s_waitcnt vmcnt(" #n ")" ::: "memory")
#define PG8_WAIT_L(n) asm volatile("s_waitcnt lgkmcnt(" #n ")" ::: "memory")
#define PG8_BAR __builtin_amdgcn_s_barrier()
#define PG8_SCHED __builtin_amdgcn_sched_barrier(0)
    Unit cur, nxt; int ui = 0;
    if (!S.next(0, cur)) return;
    f32x4 acc[2][2][4][2];
#pragma unroll
    for (int a = 0; a < 2; ++a)
#pragma unroll
        for (int b = 0; b < 2; ++b)
#pragma unroll
            for (int m = 0; m < 4; ++m)
#pragma unroll
                for (int n = 0; n < 2; ++n) acc[a][b][m][n] = (f32x4){0.f, 0.f, 0.f, 0.f};
    bf16x8 At[4][2], B0[2][2], B1[2][2];
    const char* cA = (const char*)g.A + (size_t)cur.pm * tstep; const char* cB = (const char*)g.Bt + (size_t)cur.pn * tstep;
    S.a_ready(cur);
    if constexpr (SP2) {
        PG8_STAGE(PG8_SB(0, 0), cB, voffB); PG8_STAGE(PG8_SB(0, 1), cB + hstep, voffB); PG8_STAGE(PG8_SA(0, 0), cA, voffA); PG8_STAGE(PG8_SA(0, 1), cA + hstep, voffA);
        if (wr == 1) PG8_BAR;
        PG8_WAIT_V(2); PG8_BAR;
        PG8_STAGE(PG8_SB(1, 0), cB + kstep, voffB); PG8_STAGE(PG8_SA(1, 0), cA + kstep, voffA); PG8_STAGE(PG8_SB(1, 1), cB + hstep + kstep, voffB);
        PG8_WAIT_V(6); PG8_BAR;
    } else {
        PG8_STAGE(PG8_SB(0, 0), cB, voffB); PG8_STAGE(PG8_SA(0, 0), cA, voffA); PG8_STAGE(PG8_SB(0, 1), cB + hstep, voffB); PG8_STAGE(PG8_SA(0, 1), cA + hstep, voffA);
        if (wr == 1) PG8_BAR;
        PG8_WAIT_V(4); PG8_BAR;
        PG8_STAGE(PG8_SB(1, 0), cB + kstep, voffB); PG8_STAGE(PG8_SA(1, 0), cA + kstep, voffA); PG8_STAGE(PG8_SB(1, 1), cB + hstep + kstep, voffB);
        PG8_WAIT_V(6); PG8_BAR;
    }
    for (;;) {
        const bool has_next = S.next(ui + 1, nxt);
        const char* nA = has_next ? (const char*)g.A + (size_t)nxt.pm * tstep : cA; const char* nB = has_next ? (const char*)g.Bt + (size_t)nxt.pn * tstep : cB;
        for (int t = 0; t < nt; t += 2) {
            const bool last = (t == nt - 2);
            const char* a1 = cA + (size_t)(t + 1) * kstep;
            const char* a2 = last ? nA : cA + (size_t)(t + 2) * kstep; const char* b2 = last ? nB : cB + (size_t)(t + 2) * kstep;
            const char* a3 = a2 + kstep; const char* b3 = b2 + kstep;
            if (last && has_next) S.a_ready(nxt);
            if constexpr (SP2) {
            PG8_LDB(B0, 0, 0); PG8_LDB(B1, 0, 1); PG8_SCHED; PG8_LDA(At, 0, 0); PG8_STAGE(PG8_SA(1, 1), a1 + hstep, voffA);
            PG8_WAIT_V(8); PG8_WAIT_L(0); PG8_BAR; PG8_MMA(0, 0, At, B0); PG8_MMA(0, 1, At, B1); PG8_BAR; PG8_SCHED;
            PG8_LDA(At, 0, 1); PG8_STAGE(PG8_SB(0, 0), b2, voffB); PG8_STAGE(PG8_SB(0, 1), b2 + hstep, voffB); PG8_STAGE(PG8_SA(0, 0), a2, voffA);
            PG8_WAIT_V(8); PG8_WAIT_L(0); PG8_BAR; PG8_MMA(1, 0, At, B0); PG8_MMA(1, 1, At, B1); PG8_BAR; PG8_SCHED;
            PG8_LDB(B0, 1, 0); PG8_LDB(B1, 1, 1); PG8_SCHED; PG8_LDA(At, 1, 0); PG8_STAGE(PG8_SA(0, 1), a2 + hstep, voffA);
            PG8_WAIT_V(8); PG8_WAIT_L(0); PG8_BAR; PG8_MMA(0, 0, At, B0); PG8_MMA(0, 1, At, B1); PG8_BAR; PG8_SCHED;
            PG8_LDA(At, 1, 1); PG8_STAGE(PG8_SB(1, 0), b3, voffB); PG8_STAGE(PG8_SB(1, 1), b3 + hstep, voffB); PG8_STAGE(PG8_SA(1, 0), a3, voffA);
            PG8_WAIT_V(8); PG8_WAIT_L(0); PG8_BAR; PG8_MMA(1, 0, At, B0); PG8_MMA(1, 1, At, B1); PG8_BAR; PG8_SCHED;
            } else {
            PG8_LDB(B0, 0, 0); PG8_SCHED; PG8_LDA(At, 0, 0); PG8_STAGE(PG8_SA(1, 1), a1 + hstep, voffA);
            PG8_WAIT_L(8); PG8_BAR; PG8_WAIT_L(0); PG8_MMA(0, 0, At, B0); PG8_BAR; PG8_SCHED;
            PG8_LDB(B1, 0, 1); PG8_STAGE(PG8_SB(0, 0), b2, voffB);
            PG8_BAR; PG8_WAIT_L(0); PG8_MMA(0, 1, At, B1); PG8_BAR;
            PG8_LDA(At, 0, 1); PG8_STAGE(PG8_SA(0, 0), a2, voffA);
            PG8_BAR; PG8_WAIT_L(0); PG8_MMA(1, 0, At, B0); PG8_BAR; PG8_SCHED;
            PG8_STAGE(PG8_SB(0, 1), b2 + hstep, voffB);
            PG8_WAIT_V(6); PG8_BAR; PG8_MMA(1, 1, At, B1); PG8_BAR;
            PG8_LDB(B0, 1, 0); PG8_SCHED; PG8_LDA(At, 1, 0); PG8_STAGE(PG8_SA(0, 1), a2 + hstep, voffA);
            PG8_WAIT_L(8); PG8_BAR; PG8_WAIT_L(0); PG8_MMA(0, 0, At, B0); PG8_BAR; PG8_SCHED;
            PG8_LDB(B1, 1, 1); PG8_STAGE(PG8_SB(1, 0), b3, voffB);
            PG8_BAR; PG8_WAIT_L(0); PG8_MMA(0, 1, At, B1); PG8_BAR;
            PG8_LDA(At, 1, 1); PG8_STAGE(PG8_SA(1, 0), a3, voffA);
            PG8_BAR; PG8_WAIT_L(0); PG8_MMA(1, 0, At, B0); PG8_BAR; PG8_SCHED;
            PG8_STAGE(PG8_SB(1, 1), b3 + hstep, voffB);
            PG8_WAIT_V(6); PG8_BAR; PG8_MMA(1, 1, At, B1); PG8_BAR;
            }
        }
        if constexpr (ALIGN_EPI) { if (wr == 0) PG8_BAR; }
        if constexpr (!Epi::AFTER_DRAIN) { E(acc, cur, wr, wc, fr, fq); S.done(cur); }
        if (!has_next) break;
#pragma unroll
        for (int a = 0; a < 2; ++a)
#pragma unroll
            for (int b = 0; b < 2; ++b)
#pragma unroll
                for (int m = 0; m < 4; ++m)
#pragma unroll
                    for (int n = 0; n < 2; ++n) acc[a][b][m][n] = (f32x4){0.f, 0.f, 0.f, 0.f};
        cur = nxt; cA = nA; cB = nB; ++ui;
        if constexpr (ALIGN_EPI) { if (wr == 1) PG8_BAR; }
    }
    PG8_WAIT_V(0);
    if constexpr (!ALIGN_EPI) { if (wr == 0) PG8_BAR; }
    PG8_BAR;
    if constexpr (Epi::AFTER_DRAIN) { E.fused(acc, cur, wr, wc, fr, fq, lds, wid, lane); S.done(cur); }
#undef PG8_SA
#undef PG8_SB
#undef PG8_STAGE
#undef PG8_LDA
#undef PG8_LDB
#undef PG8_MMA
#undef PG8_WAIT_V
#undef PG8_WAIT_L
#undef PG8_BAR
#undef PG8_SCHED
}
}

__device__ __forceinline__ void phase_rinv(const Params& p) {
    const int lane = threadIdx.x & 63, gw = blockIdx.x * 8 + (threadIdx.x >> 6), ngw = gridDim.x * 8;
    const bf16_t* cq = (const bf16_t*)(p.ws + WS_CQ); const bf16_t* ckv = (const bf16_t*)(p.ws + WS_CKV);
    float* rq = (float*)(p.ws + WS_RINVQ); float* rkv = (float*)(p.ws + WS_RINVKV);
    for (int row = gw; row < T; row += ngw) {
        float s = 0.f;
        for (int c = lane; c < QR; c += 64) { const float v = bf2f(cq[(size_t)row * QR + c]); s += v * v; }
        s = wave_sum(s);
        float s2 = 0.f;
        for (int c = lane; c < KVR; c += 64) { const float v = bf2f(ckv[(size_t)row * KVR + c]); s2 += v * v; }
        s2 = wave_sum(s2);
        if (lane == 0) { rq[row] = 1.0f / sqrtf(s / (float)QR + EPS); rkv[row] = 1.0f / sqrtf(s2 / (float)KVR + EPS); }
    }
}

namespace ret {
typedef __attribute__((address_space(3))) unsigned char* lptr;
typedef short s16x4 __attribute__((ext_vector_type(4)));
typedef float f32x2_t __attribute__((ext_vector_type(2))); typedef __bf16 bf16x2_t __attribute__((ext_vector_type(2)));
__device__ __forceinline__ unsigned cvtpk_s(float lo, float hi) { f32x2_t v = {lo, hi}; bf16x2_t b = __builtin_convertvector(v, bf16x2_t); return __builtin_bit_cast(unsigned, b); }
__device__ __forceinline__ s16x4 vtr(lptr p) { return __builtin_bit_cast(s16x4, __builtin_amdgcn_ds_read_tr16_b64_v4i16((__attribute__((address_space(3))) s16x4*)p)); }
__device__ __forceinline__ bf16x8 cat8(s16x4 lo, s16x4 hi) { return (bf16x8){lo[0], lo[1], lo[2], lo[3], hi[0], hi[1], hi[2], hi[3]}; }
__device__ __forceinline__ u32x4 scale8(u32x4 w, float s) {
    u32x4 o;
    o.x = cvtpk_s(bf2f(w.x & 0xffffu) * s, bf2f(w.x >> 16) * s); o.y = cvtpk_s(bf2f(w.y & 0xffffu) * s, bf2f(w.y >> 16) * s);
    o.z = cvtpk_s(bf2f(w.z & 0xffffu) * s, bf2f(w.z >> 16) * s); o.w = cvtpk_s(bf2f(w.w & 0xffffu) * s, bf2f(w.w >> 16) * s); return o;
}
__device__ __forceinline__ float logg(int h) { return log1pf(-exp2f(-5.0f - (float)h)); }

constexpr int KT_RS = 320, VT_RS = 192, KT_OFF = 0, VT_OFF = 64 * KT_RS, SPT_OFF = VT_OFF + 64 * VT_RS, SPT_RS = 256, SCAN_LDS = SPT_OFF + 64 * SPT_RS;
__device__ __forceinline__ void scan_item(lptr lds, const bf16_t* RK, const bf16_t* RV, bf16_t* SP, int bh, int eh) {
    const int tid = threadIdx.x, wid = __builtin_amdgcn_readfirstlane(tid >> 6), lane = tid & 63, r32 = lane & 31, hi = lane >> 5;
    const int g1 = (lane >> 4) & 1, q = (lane & 15) >> 2, pq = lane & 3;
    const int b = bh / RH, h = bh % RH, eb2 = wid >> 2, db = wid & 3;
    const float lg = logg(h), cd = expf(64.f * lg);
    const int kr0 = tid >> 4, kc = tid & 15, vr = tid >> 3, vc = tid & 7;
    const float dk0 = expf(lg * (float)(63 - kr0)), dk1 = expf(lg * (float)(63 - (kr0 + 32)));
    const bf16_t* kg = RK + ((size_t)b * SEQ + kr0) * 1024 + h * 128 + kc * 8;
    const bf16_t* vg = RV + ((size_t)b * SEQ + vr) * 1024 + h * 128 + eh * 64 + vc * 8;
    lptr kw = lds + KT_OFF + kr0 * KT_RS + kc * 16, vw = lds + VT_OFF + vr * VT_RS + vc * 16;
    lptr ar = lds + VT_OFF + (8 * hi + q) * VT_RS + (32 * eb2 + 16 * g1 + 4 * pq) * 2;
    lptr br = lds + KT_OFF + (8 * hi + q) * KT_RS + (32 * db + 16 * g1 + 4 * pq) * 2;
    f32x16 acc;
#pragma unroll
    for (int r = 0; r < 16; ++r) acc[r] = 0.f;
    u32x4 k0 = *(const u32x4*)kg, k1 = *(const u32x4*)(kg + 32 * 1024), v0 = *(const u32x4*)vg;
    __syncthreads();
    *(__attribute__((address_space(3))) u32x4*)kw = scale8(k0, dk0); *(__attribute__((address_space(3))) u32x4*)(kw + 32 * KT_RS) = scale8(k1, dk1); *(__attribute__((address_space(3))) u32x4*)vw = v0;
    k0 = *(const u32x4*)(kg + 64 * 1024); k1 = *(const u32x4*)(kg + 96 * 1024); v0 = *(const u32x4*)(vg + 64 * 1024);
    __syncthreads();
    bf16_t* spg = SP + ((size_t)bh * NCH * 128 + eh * 64) * 128;
    for (int n = 0; n < NCH; ++n) {
#pragma unroll
        for (int r = 0; r < 16; ++r) *(__attribute__((address_space(3))) bf16_t*)(lds + SPT_OFF + (32 * eb2 + crow(r, hi)) * SPT_RS + (32 * db + r32) * 2) = (bf16_t)f2bf(acc[r]);
#pragma unroll
        for (int r = 0; r < 16; ++r) acc[r] *= cd;
#pragma unroll
        for (int ks = 0; ks < 4; ++ks) {
            const bf16x8 a = cat8(vtr(ar + (16 * ks) * VT_RS), vtr(ar + (16 * ks + 4) * VT_RS));
            const bf16x8 bq = cat8(vtr(br + (16 * ks) * KT_RS), vtr(br + (16 * ks + 4) * KT_RS));
            acc = __builtin_amdgcn_mfma_f32_32x32x16_bf16(a, bq, acc, 0, 0, 0);
        }
        __syncthreads();
        { bf16_t* dst = spg + (size_t)n * 128 * 128;
#pragma unroll
          for (int i = 0; i < 2; ++i) { const int c = tid + 512 * i, e = c >> 4, ch = c & 15;
              *(u32x4*)(dst + (size_t)e * 128 + ch * 8) = *(const __attribute__((address_space(3))) u32x4*)(lds + SPT_OFF + e * SPT_RS + ch * 16); } }
        if (n + 1 < NCH) {
            *(__attribute__((address_space(3))) u32x4*)kw = scale8(k0, dk0); *(__attribute__((address_space(3))) u32x4*)(kw + 32 * KT_RS) = scale8(k1, dk1); *(__attribute__((address_space(3))) u32x4*)vw = v0;
            if (n + 2 < NCH) { const size_t o = (size_t)(n + 2) * 64 * 1024; k0 = *(const u32x4*)(kg + o); k1 = *(const u32x4*)(kg + o + 32 * 1024); v0 = *(const u32x4*)(vg + o); }
        }
        __syncthreads();
    }
}

constexpr int QK_RS = 272, V_RS = 320, OQ_OFF = 0, OK_OFF = 64 * QK_RS, OV_OFF = 2 * 64 * QK_RS, OO_OFF = OV_OFF + 64 * V_RS, OO_LD = 132, OUT_LDS = OO_OFF + 64 * OO_LD * 4;
__device__ __forceinline__ void out_item(lptr lds, const bf16_t* RQ, const bf16_t* RK, const bf16_t* RV, const bf16_t* RG, const bf16_t* SP, const float* gn_g, bf16_t* MIX, int it) {
    const int tid = threadIdx.x, wid = __builtin_amdgcn_readfirstlane(tid >> 6), lane = tid & 63, r32 = lane & 31, hi = lane >> 5;
    const int g1 = (lane >> 4) & 1, q = (lane & 15) >> 2, pq = lane & 3;
    const int bh = it / NCH, n = it % NCH, b = bh / RH, h = bh % RH, ib = wid >> 2, eb = wid & 3;
    const float lg2 = logg(h) * 1.4426950408889634f;
    const size_t t0 = (size_t)b * SEQ + (size_t)n * CH;
    {
        const int r0 = tid >> 4, c16 = tid & 15; const size_t go = (t0 + r0) * 1024 + h * 128 + c16 * 8;
        const u32x4 q0 = *(const u32x4*)(RQ + go), q1 = *(const u32x4*)(RQ + go + 32 * 1024), k0 = *(const u32x4*)(RK + go), k1 = *(const u32x4*)(RK + go + 32 * 1024),
                    v0 = *(const u32x4*)(RV + go), v1 = *(const u32x4*)(RV + go + 32 * 1024);
        __syncthreads();
        *(__attribute__((address_space(3))) u32x4*)(lds + OQ_OFF + r0 * QK_RS + c16 * 16) = q0; *(__attribute__((address_space(3))) u32x4*)(lds + OQ_OFF + (r0 + 32) * QK_RS + c16 * 16) = q1;
        *(__attribute__((address_space(3))) u32x4*)(lds + OK_OFF + r0 * QK_RS + c16 * 16) = k0; *(__attribute__((address_space(3))) u32x4*)(lds + OK_OFF + (r0 + 32) * QK_RS + c16 * 16) = k1;
        *(__attribute__((address_space(3))) u32x4*)(lds + OV_OFF + r0 * V_RS + c16 * 16) = v0; *(__attribute__((address_space(3))) u32x4*)(lds + OV_OFF + (r0 + 32) * V_RS + c16 * 16) = v1;
        __syncthreads();
    }
    f32x16 acc;
#pragma unroll
    for (int r = 0; r < 16; ++r) acc[r] = 0.f;
    lptr qa = lds + OQ_OFF + (32 * ib + r32) * QK_RS + hi * 16;
    const bf16_t* spb = SP + ((size_t)it * 128 + 32 * eb + r32) * 128 + hi * 8;
#pragma unroll
    for (int ks = 0; ks < 8; ++ks) {
        const bf16x8 a = *(const __attribute__((address_space(3))) bf16x8*)(qa + ks * 32);
        const bf16x8 bq = *(const bf16x8*)(spb + ks * 16);
        acc = __builtin_amdgcn_mfma_f32_32x32x16_bf16(a, bq, acc, 0, 0, 0);
    }
#pragma unroll
    for (int r = 0; r < 16; ++r) acc[r] *= __builtin_amdgcn_exp2f(lg2 * (float)(32 * ib + crow(r, hi) + 1));
    lptr vbase = lds + OV_OFF + (4 * hi + q) * V_RS + (32 * eb + 16 * g1 + 4 * pq) * 2;
#pragma unroll
    for (int jb = 0; jb < 2; ++jb) {
        f32x16 x;
#pragma unroll
        for (int r = 0; r < 16; ++r) x[r] = 0.f;
        lptr ka = lds + OK_OFF + (32 * jb + r32) * QK_RS + hi * 16;
#pragma unroll
        for (int ks = 0; ks < 8; ++ks) {
            const bf16x8 a = *(const __attribute__((address_space(3))) bf16x8*)(ka + ks * 32);
            const bf16x8 bq = *(const __attribute__((address_space(3))) bf16x8*)(qa + ks * 32);
            x = __builtin_amdgcn_mfma_f32_32x32x16_bf16(a, bq, x, 0, 0, 0);
        }
        const int iq = 32 * ib + r32;
#pragma unroll
        for (int r = 0; r < 16; ++r) { const int j = 32 * jb + crow(r, hi); const int dist = iq > j ? iq - j : j - iq; x[r] *= __builtin_amdgcn_exp2f(lg2 * (float)dist); }
#pragma unroll
        for (int s = 0; s < 2; ++s) {
            u32x4 w; w.x = cvtpk_s(x[8 * s + 0], x[8 * s + 1]); w.y = cvtpk_s(x[8 * s + 2], x[8 * s + 3]); w.z = cvtpk_s(x[8 * s + 4], x[8 * s + 5]); w.w = cvtpk_s(x[8 * s + 6], x[8 * s + 7]);
            const bf16x8 pa = __builtin_bit_cast(bf16x8, w);
            const bf16x8 vb = cat8(vtr(vbase + (32 * jb + 16 * s) * V_RS), vtr(vbase + (32 * jb + 16 * s + 8) * V_RS));
            acc = __builtin_amdgcn_mfma_f32_32x32x16_bf16(pa, vb, acc, 0, 0, 0);
        }
    }
    __attribute__((address_space(3))) float* oo = (__attribute__((address_space(3))) float*)(lds + OO_OFF);
#pragma unroll
    for (int r = 0; r < 16; ++r) oo[(32 * ib + crow(r, hi)) * OO_LD + 32 * eb + r32] = acc[r];
    __syncthreads();
    {
        const int i = tid >> 3, e0 = (tid & 7) * 16;
        f32x4 v[4]; float s1 = 0.f;
#pragma unroll
        for (int k = 0; k < 4; ++k) { v[k] = *(const __attribute__((address_space(3))) f32x4*)(oo + i * OO_LD + e0 + 4 * k); s1 += (v[k].x + v[k].y) + (v[k].z + v[k].w); }
        s1 += __shfl_xor(s1, 1); s1 += __shfl_xor(s1, 2); s1 += __shfl_xor(s1, 4);
        const float mu = s1 * (1.f / 128.f); float s2 = 0.f;
#pragma unroll
        for (int k = 0; k < 4; ++k) { v[k] = v[k] - mu; s2 += (v[k].x * v[k].x + v[k].y * v[k].y) + (v[k].z * v[k].z + v[k].w * v[k].w); }
        s2 += __shfl_xor(s2, 1); s2 += __shfl_xor(s2, 2); s2 += __shfl_xor(s2, 4);
        const float rstd = 1.0f / sqrtf(s2 * (1.f / 128.f) + EPS);
        const size_t trow = t0 + i; const int c0 = h * 128 + e0;
        const u32x4 gw0 = *(const u32x4*)(RG + trow * 1024 + c0), gw1 = *(const u32x4*)(RG + trow * 1024 + c0 + 8);
        float gt[16];
        gt[0] = bf2f(gw0.x & 0xffffu); gt[1] = bf2f(gw0.x >> 16); gt[2] = bf2f(gw0.y & 0xffffu); gt[3] = bf2f(gw0.y >> 16); gt[4] = bf2f(gw0.z & 0xffffu); gt[5] = bf2f(gw0.z >> 16); gt[6] = bf2f(gw0.w & 0xffffu); gt[7] = bf2f(gw0.w >> 16);
        gt[8] = bf2f(gw1.x & 0xffffu); gt[9] = bf2f(gw1.x >> 16); gt[10] = bf2f(gw1.y & 0xffffu); gt[11] = bf2f(gw1.y >> 16); gt[12] = bf2f(gw1.z & 0xffffu); gt[13] = bf2f(gw1.z >> 16); gt[14] = bf2f(gw1.w & 0xffffu); gt[15] = bf2f(gw1.w >> 16);
        float ov[16];
#pragma unroll
        for (int k = 0; k < 4; ++k) { const f32x4 gg = *(const f32x4*)(gn_g + c0 + 4 * k);
#pragma unroll
            for (int j = 0; j < 4; ++j) { const float gv = gt[4 * k + j]; const float sg = gv / (1.f + __builtin_amdgcn_exp2f(-gv * 1.4426950408889634f)); ov[4 * k + j] = sg * v[k][j] * rstd * gg[j]; } }
        u32x4 w0, w1;
        w0.x = cvtpk_s(ov[0], ov[1]); w0.y = cvtpk_s(ov[2], ov[3]); w0.z = cvtpk_s(ov[4], ov[5]); w0.w = cvtpk_s(ov[6], ov[7]);
        w1.x = cvtpk_s(ov[8], ov[9]); w1.y = cvtpk_s(ov[10], ov[11]); w1.z = cvtpk_s(ov[12], ov[13]); w1.w = cvtpk_s(ov[14], ov[15]);
        *(u32x4*)(MIX + trow * DM + c0) = w0; *(u32x4*)(MIX + trow * DM + c0 + 8) = w1;
    }
}
}

namespace attn {
typedef __attribute__((address_space(3))) unsigned char* lptr;
typedef short s16x4 __attribute__((ext_vector_type(4)));
constexpr int KN_OFF = 0, KR_OFF = 16384, V_OFF = 24576, BUF = 40960, SCR_OFF = 2 * BUF, LDS_NEED = SCR_OFF + 8 * 256;
constexpr float THR = 8.f;

__device__ __forceinline__ int v_rd_base(int lane) { return ((lane & 3) << 3) | (((lane >> 2) & 3) << 6) | (((lane >> 4) & 1) << 5) | (((lane >> 5) & 1) << 8); }
constexpr int v_rd_off(int d0, int ks, int half) { return d0 * 512 + ks * 4096 + half * 2048; }
__device__ __forceinline__ unsigned cvtpk(float lo, float hi) { unsigned r; asm volatile("v_cvt_pk_bf16_f32 %0, %1, %2" : "=v"(r) : "v"(lo), "v"(hi)); return r; }
__device__ __forceinline__ s16x4 vtr(lptr p) { return __builtin_bit_cast(s16x4, __builtin_amdgcn_ds_read_tr16_b64_v4i16((__attribute__((address_space(3))) s16x4*)p)); }
__device__ __forceinline__ void dma16(const void* g, lptr l) { __builtin_amdgcn_global_load_lds((const unsigned*)g, (__attribute__((address_space(3))) unsigned*)l, 16, 0, 0); }

struct Src { unsigned kn[2], kr, v[2]; };
__device__ __forceinline__ Src make_src(int wid, int lane) {
    Src s;
#pragma unroll
    for (int i = 0; i < 2; ++i) { const int pi = wid + 8 * i;
        { const int row = 4 * pi + (lane >> 4), colB = ((lane & 15) << 4) ^ ((row & 7) << 4); s.kn[i] = (unsigned)(row * 1024 + colB / 2); }
        { const int sub = 2 * pi + (lane >> 5), kk = (sub >> 2) * 8 + ((lane & 31) >> 2), key = (kk & ~0xC) | ((kk & 4) << 1) | ((kk & 8) >> 1), col = (sub & 3) * 32 + (lane & 3) * 8;
          s.v[i] = (unsigned)(key * 1024 + col); } }
    { const int row = 8 * wid + (lane >> 3), chunk = (lane & 7) ^ ((row >> 1) & 7); s.kr = (unsigned)(row * 64 + chunk * 8); }
    return s;
}

__device__ __forceinline__ void attn_unit(lptr lds, const bf16_t* MQ, const bf16_t* MKN, const bf16_t* KR, const bf16_t* MV, bf16_t* MIX, int b, int h, int qb) {
    const int tid = threadIdx.x, wid = __builtin_amdgcn_readfirstlane(tid >> 6), lane = tid & 63, r32 = lane & 31, hi = lane >> 5;
    const int NT = 4 * qb + 4, cw = 4 * qb + (wid >> 1);
    const size_t tb = (size_t)b * SEQ;
    const Src src = make_src(wid, lane);
    const bf16_t* knb = MKN + tb * 1024 + h * 128; const bf16_t* krb = KR + tb * 64; const bf16_t* vb = MV + tb * 1024 + h * 128;
#define ATT_STAGE(t, buf) do { const size_t ro_ = (size_t)(t) * 64; lptr lb_ = lds + (buf) * BUF + wid * 1024; \
        dma16(knb + ro_ * 1024 + src.kn[0], lb_ + KN_OFF); dma16(knb + ro_ * 1024 + src.kn[1], lb_ + KN_OFF + 8192); \
        dma16(krb + ro_ * 64 + src.kr, lb_ + KR_OFF); \
        dma16(vb + ro_ * 1024 + src.v[0], lb_ + V_OFF); dma16(vb + ro_ * 1024 + src.v[1], lb_ + V_OFF + 8192); } while (0)
    ATT_STAGE(0, 0);
    const size_t qrow = tb + (size_t)qb * 256 + wid * 32 + r32;
    bf16x8 qr[12];
#pragma unroll
    for (int d0 = 0; d0 < 8; ++d0) qr[d0] = *(const bf16x8*)(MQ + qrow * (MH * QKD) + h * NOPE + d0 * 16 + hi * 8);
#pragma unroll
    for (int d0 = 0; d0 < 4; ++d0) qr[8 + d0] = *(const bf16x8*)(MQ + qrow * (MH * QKD) + MH * NOPE + h * ROPE + d0 * 16 + hi * 8);
    float m_reg = -1e30f, l_reg = 0.f;
    f32x16 o[4];
#pragma unroll
    for (int d = 0; d < 4; ++d)
#pragma unroll
        for (int r = 0; r < 16; ++r) o[d][r] = 0.f;
    __attribute__((address_space(3))) float* scr = (__attribute__((address_space(3))) float*)(lds + SCR_OFF + wid * 256);
    int kno[4], kro[4];
#pragma unroll
    for (int dd = 0; dd < 4; ++dd) { kno[dd] = r32 * 256 + (((dd * 16 + hi * 8) * 2) ^ ((r32 & 7) << 4)); kro[dd] = r32 * 128 + 16 * ((2 * dd + hi) ^ ((r32 >> 1) & 7)); }
    const int vro = v_rd_base(lane);
    asm volatile("s_waitcnt vmcnt(0)" ::: "memory"); __builtin_amdgcn_s_barrier(); asm volatile("" ::: "memory");
    for (int t = 0; t < NT; ++t) {
        const int cur = t & 1;
        if (t + 1 < NT) ATT_STAGE(t + 1, cur ^ 1);
        if (t <= cw) {
            lptr kn = lds + cur * BUF + KN_OFF, kr = lds + cur * BUF + KR_OFF, vv = lds + cur * BUF + V_OFF + vro;
            f32x16 p0, p1;
#pragma unroll
            for (int r = 0; r < 16; ++r) { p0[r] = 0.f; p1[r] = 0.f; }
#pragma unroll
            for (int d0 = 0; d0 < 8; ++d0) { lptr a = kn + kno[d0 & 3] + (d0 >> 2) * 128;
                const bf16x8 b0 = *(const __attribute__((address_space(3))) bf16x8*)a, b1 = *(const __attribute__((address_space(3))) bf16x8*)(a + 32 * 256);
                p0 = __builtin_amdgcn_mfma_f32_32x32x16_bf16(b0, qr[d0], p0, 0, 0, 0); p1 = __builtin_amdgcn_mfma_f32_32x32x16_bf16(b1, qr[d0], p1, 0, 0, 0); }
#pragma unroll
            for (int d0 = 0; d0 < 4; ++d0) { lptr a = kr + kro[d0];
                const bf16x8 b0 = *(const __attribute__((address_space(3))) bf16x8*)a, b1 = *(const __attribute__((address_space(3))) bf16x8*)(a + 32 * 128);
                p0 = __builtin_amdgcn_mfma_f32_32x32x16_bf16(b0, qr[8 + d0], p0, 0, 0, 0); p1 = __builtin_amdgcn_mfma_f32_32x32x16_bf16(b1, qr[8 + d0], p1, 0, 0, 0); }
            float pmax = p0[0];
#pragma unroll
            for (int r = 1; r < 16; ++r) pmax = fmaxf(pmax, p0[r]);
#pragma unroll
            for (int r = 0; r < 16; ++r) pmax = fmaxf(pmax, p1[r]);
            { auto rr = __builtin_amdgcn_permlane32_swap(__float_as_uint(pmax), __float_as_uint(pmax), false, false); pmax = fmaxf(__uint_as_float(rr[0]), __uint_as_float(rr[1])); }
            float mn, alpha;
            if (__all(pmax - m_reg <= THR)) { mn = m_reg; alpha = 1.f; }
            else { mn = fmaxf(m_reg, pmax); alpha = __builtin_amdgcn_exp2f(m_reg - mn); m_reg = mn; }
#pragma unroll
            for (int r = 0; r < 16; ++r) { p0[r] = __builtin_amdgcn_exp2f(p0[r] - mn); p1[r] = __builtin_amdgcn_exp2f(p1[r] - mn); }
            float ps = 0.f;
#pragma unroll
            for (int r = 0; r < 16; ++r) ps += p0[r] + p1[r];
            { auto rr = __builtin_amdgcn_permlane32_swap(__float_as_uint(ps), __float_as_uint(ps), false, false); ps = __uint_as_float(rr[0]) + __uint_as_float(rr[1]); }
            l_reg = l_reg * alpha + ps;
            bf16x8 pa0, pa1, pa2, pa3;
#define ATT_PK4(P, B_, OUT) do { unsigned a0 = cvtpk(P[B_ + 0], P[B_ + 1]), a1 = cvtpk(P[B_ + 2], P[B_ + 3]); unsigned b0 = cvtpk(P[B_ + 4], P[B_ + 5]), b1 = cvtpk(P[B_ + 6], P[B_ + 7]); \
        auto r0 = __builtin_amdgcn_permlane32_swap(a0, b0, false, false); auto r1 = __builtin_amdgcn_permlane32_swap(a1, b1, false, false); \
        u32x4 w = {r0[0], r1[0], r0[1], r1[1]}; OUT = __builtin_bit_cast(bf16x8, w); } while (0)
            ATT_PK4(p0, 0, pa0); ATT_PK4(p0, 8, pa1); ATT_PK4(p1, 0, pa2); ATT_PK4(p1, 8, pa3);
#undef ATT_PK4
            if (__any(alpha < 1.f)) { if (hi == 0) scr[r32] = alpha; asm volatile("s_waitcnt lgkmcnt(0)" ::: "memory");
#pragma unroll
                for (int r = 0; r < 16; ++r) { const float a = scr[crow(r, hi)];
#pragma unroll
                    for (int d = 0; d < 4; ++d) o[d][r] *= a; } }
#pragma unroll
            for (int d0 = 0; d0 < 4; ++d0) {
                s16x4 lo[4], hh[4];
#pragma unroll
                for (int ks = 0; ks < 4; ++ks) { lo[ks] = vtr(vv + v_rd_off(d0, ks, 0)); hh[ks] = vtr(vv + v_rd_off(d0, ks, 1)); }
#define ATT_VF(k) (bf16x8){lo[k][0], lo[k][1], lo[k][2], lo[k][3], hh[k][0], hh[k][1], hh[k][2], hh[k][3]}
                o[d0] = __builtin_amdgcn_mfma_f32_32x32x16_bf16(pa0, ATT_VF(0), o[d0], 0, 0, 0);
                o[d0] = __builtin_amdgcn_mfma_f32_32x32x16_bf16(pa1, ATT_VF(1), o[d0], 0, 0, 0);
                o[d0] = __builtin_amdgcn_mfma_f32_32x32x16_bf16(pa2, ATT_VF(2), o[d0], 0, 0, 0);
                o[d0] = __builtin_amdgcn_mfma_f32_32x32x16_bf16(pa3, ATT_VF(3), o[d0], 0, 0, 0);
#undef ATT_VF
            }
        }
        asm volatile("s_waitcnt vmcnt(0) lgkmcnt(0)" ::: "memory"); __builtin_amdgcn_s_barrier(); asm volatile("" ::: "memory");
    }
#undef ATT_STAGE
    if (hi == 0) scr[32 + r32] = l_reg;
    asm volatile("s_waitcnt lgkmcnt(0)" ::: "memory");
    bf16_t* Ow = MIX + (tb + (size_t)qb * 256 + wid * 32) * DM + 1024 + h * 128;
#pragma unroll
    for (int r = 0; r < 16; ++r) { const int orow = crow(r, hi); const float rl = __builtin_amdgcn_rcpf(scr[32 + orow]);
#pragma unroll
        for (int d0 = 0; d0 < 4; ++d0) { const float v = o[d0][r] * rl; const float vn = __shfl_xor(v, 1);
            if ((r32 & 1) == 0) *(unsigned*)(Ow + (size_t)orow * DM + d0 * 32 + r32) = cvtpk(v, vn); } }
    asm volatile("s_waitcnt lgkmcnt(0)" ::: "memory");
}

__device__ __forceinline__ void attn_phase(lptr lds, const bf16_t* MQ, const bf16_t* MKN, const bf16_t* KR, const bf16_t* MV, bf16_t* MIX) {
    const int G = gridDim.x, bx = blockIdx.x, vcu = (G % 8 == 0) ? (bx % 8) * (G / 8) + bx / 8 : bx;
    for (int u = vcu; u < NB * MH * 8; u += G) {
        const int bh = u >> 3, s = u & 7;
        attn_unit(lds, MQ, MKN, KR, MV, MIX, bh / MH, bh % MH, 15 - s);
        attn_unit(lds, MQ, MKN, KR, MV, MIX, bh / MH, bh % MH, s);
    }
}
}

__device__ __forceinline__ void phase_ln(float* y, const float* g, const float* bta, bf16_t* yb) {
    const int lane = threadIdx.x & 63, gw = blockIdx.x * 8 + (threadIdx.x >> 6), ngw = gridDim.x * 8;
    for (int row = gw; row < T; row += ngw) {
        f32x4* yr = (f32x4*)(y + (size_t)row * DM) + lane;
        f32x4 v[8]; float s = 0.f;
#pragma unroll
        for (int j = 0; j < 8; ++j) { v[j] = yr[64 * j]; s += (v[j].x + v[j].y) + (v[j].z + v[j].w); }
        const float mean = wave_sum(s) * (1.f / DM); float s2 = 0.f;
#pragma unroll
        for (int j = 0; j < 8; ++j) { v[j] = v[j] - mean; s2 += (v[j].x * v[j].x + v[j].y * v[j].y) + (v[j].z * v[j].z + v[j].w * v[j].w); }
        const float rstd = 1.0f / sqrtf(wave_sum(s2) * (1.f / DM) + EPS);
#pragma unroll
        for (int j = 0; j < 8; ++j) { const int c = 4 * lane + 256 * j; const f32x4 gg = *(const f32x4*)(g + c), bb = *(const f32x4*)(bta + c);
            const f32x4 o = v[j] * rstd * gg + bb; yr[64 * j] = o;
            if (yb) { u32x2 w; w.x = pk2(o.x, o.y); w.y = pk2(o.z, o.w); *(u32x2*)(yb + (size_t)row * DM + c) = w; } }
    }
}

__global__ void __launch_bounds__(NTHREADS, 2) mk_fwd(Params p) {
    extern __shared__ __attribute__((aligned(16))) unsigned char lds[];
    cg::grid_group grid = cg::this_grid();
    unsigned char* ws = p.ws;
#define IN(k) (p.ph_lo <= (k) && (k) < p.ph_hi)
#define SEAM(k) do { if (IN(k) && IN((k) + 1)) grid.sync(); } while (0)
    if (IN(0)) phase_prep(p, lds);
    SEAM(0);
    if (IN(1)) { pg8::Gemm g{(const bf16_t*)(ws + WS_XB), (const bf16_t*)(ws + WS_WIN), T, INWP, DM}; pg8::StaticOrder S; S.init(T, INWP, gridDim.x, blockIdx.x);
        pg8::EpiProj e{ws};
        pg8::gemm_phase<pg8::EpiProj, pg8::StaticOrder, true, true>((PG8_LAS unsigned char*)lds, g, S, e); }
    SEAM(1);
    if (IN(2)) phase_rinv(p);
    SEAM(2);
    if (IN(3)) {
        for (int it = blockIdx.x; it < NB * RH * 2; it += gridDim.x) ret::scan_item((ret::lptr)lds, (const bf16_t*)(ws + WS_RK), (const bf16_t*)(ws + WS_RV), (bf16_t*)(ws + WS_SP), it >> 1, it & 1);
        __syncthreads();
        { pg8::Gemm g{(const bf16_t*)(ws + WS_CQ), (const bf16_t*)(ws + WS_WUQ), T, MH * QKD, QR}; pg8::StaticOrder S; S.init(T, MH * QKD, gridDim.x, gridDim.x - 1 - blockIdx.x);
          pg8::EpiQ e{(bf16_t*)(ws + WS_MQ), (const float*)(ws + WS_RINVQ), (const float*)(ws + WS_R64)};
          pg8::gemm_phase<pg8::EpiQ, pg8::StaticOrder, true, true>((PG8_LAS unsigned char*)lds, g, S, e); }
        { pg8::Gemm g{(const bf16_t*)(ws + WS_CKV), (const bf16_t*)(ws + WS_WUKV), T, 2048, KVR}; pg8::StaticOrder S; S.init(T, 2048, gridDim.x, blockIdx.x);
          pg8::EpiKV e{ws, (const float*)(ws + WS_RINVKV)};
          pg8::gemm_phase<pg8::EpiKV, pg8::StaticOrder, true, true>((PG8_LAS unsigned char*)lds, g, S, e); }
        __syncthreads();
    }
    SEAM(3);
    if (IN(4)) {
        attn::attn_phase((attn::lptr)lds, (const bf16_t*)(ws + WS_MQ), (const bf16_t*)(ws + WS_MKN), (const bf16_t*)(ws + WS_KR), (const bf16_t*)(ws + WS_MV), (bf16_t*)(ws + WS_MIX)); }
    SEAM(4);
    if (IN(5)) { for (int it = blockIdx.x; it < NB * RH * NCH; it += gridDim.x)
            ret::out_item((ret::lptr)lds, (const bf16_t*)(ws + WS_RQ), (const bf16_t*)(ws + WS_RK), (const bf16_t*)(ws + WS_RV), (const bf16_t*)(ws + WS_RG), (const bf16_t*)(ws + WS_SP), p.ret_gn_g, (bf16_t*)(ws + WS_MIX), it); }
    SEAM(5);
    if (IN(6)) { pg8::Gemm g{(const bf16_t*)(ws + WS_MIX), (const bf16_t*)(ws + WS_WOUT), T, DM, DM}; pg8::StaticOrder S; S.init(T, DM, gridDim.x, blockIdx.x);
        pg8::EpiResF32 e{p.x, p.out};
        pg8::gemm_phase<pg8::EpiResF32, pg8::StaticOrder, true, true>((PG8_LAS unsigned char*)lds, g, S, e); }
    SEAM(6);
    if (IN(7)) phase_ln(p.out, p.ln1_g, p.ln1_b, (bf16_t*)(ws + WS_X1B));
    SEAM(7);
    if (IN(8)) { pg8::Gemm g{(const bf16_t*)(ws + WS_X1B), (const bf16_t*)(ws + WS_WUP), T, DFF, DM}; pg8::StaticOrder S; S.init(T, DFF, gridDim.x, blockIdx.x);
        pg8::EpiRelu2 e{(bf16_t*)(ws + WS_HDN)};
        pg8::gemm_phase<pg8::EpiRelu2, pg8::StaticOrder, true, true>((PG8_LAS unsigned char*)lds, g, S, e); }
    SEAM(8);
    if (IN(9)) { pg8::Gemm g{(const bf16_t*)(ws + WS_HDN), (const bf16_t*)(ws + WS_WDN), T, DM, DFF}; pg8::StaticOrder S; S.init(T, DM, gridDim.x, blockIdx.x);
        pg8::EpiResF32 e{p.out, p.out};
        pg8::gemm_phase<pg8::EpiResF32, pg8::StaticOrder, true, true>((PG8_LAS unsigned char*)lds, g, S, e); }
    SEAM(9);
    if (IN(10)) phase_ln(p.out, p.ln2_g, p.ln2_b, nullptr);
#undef IN
#undef SEAM
}

extern "C" void kernel_launch(void* const* d_in, const int* in_sizes, int n_in, void* d_out, int out_size, void* d_ws, size_t ws_size, hipStream_t stream) {
    static int grid = 0;
    if (grid == 0) {
        if (n_in != 16 || in_sizes[0] != T * DM || out_size != T * DM || ws_size < WS_END) {
            fprintf(stderr, "kernel_launch: unexpected shapes n_in %d in0 %d out %d ws %zu\n", n_in, n_in > 0 ? in_sizes[0] : -1, out_size, ws_size); grid = -1; return; }
        int dev = 0, cus = 0, per_cu = 0;
        hipGetDevice(&dev); hipDeviceGetAttribute(&cus, hipDeviceAttributeMultiprocessorCount, dev);
        hipFuncSetAttribute((const void*)mk_fwd, hipFuncAttributeMaxDynamicSharedMemorySize, LDS_BYTES);
        hipOccupancyMaxActiveBlocksPerMultiprocessor(&per_cu, (const void*)mk_fwd, NTHREADS, LDS_BYTES);
        if (per_cu < 1) { fprintf(stderr, "kernel_launch: occupancy query says %d blocks per CU\n", per_cu); per_cu = 1; }
        (void)hipGetLastError();
        grid = cus;
    }
    if (grid < 0) return;
    Params p{};
    p.x = (const float*)d_in[0]; p.pos = (const int*)d_in[1]; p.w_in = (const float*)d_in[2]; p.q_norm_g = (const float*)d_in[3];
    p.w_uq = (const float*)d_in[4]; p.kv_norm_g = (const float*)d_in[5]; p.w_uk = (const float*)d_in[6]; p.w_uv = (const float*)d_in[7];
    p.ret_gn_g = (const float*)d_in[8]; p.w_out = (const float*)d_in[9]; p.ln1_g = (const float*)d_in[10]; p.ln1_b = (const float*)d_in[11];
    p.w_up = (const float*)d_in[12]; p.w_down = (const float*)d_in[13]; p.ln2_g = (const float*)d_in[14]; p.ln2_b = (const float*)d_in[15];
    p.out = (float*)d_out; p.ws = (unsigned char*)d_ws; p.ph_lo = 0; p.ph_hi = 11;
    void* args[] = {&p};
    hipError_t e = hipLaunchCooperativeKernel((const void*)mk_fwd, dim3(grid), dim3(NTHREADS), args, LDS_BYTES, stream);
    if (e != hipSuccess) fprintf(stderr, "cooperative launch failed: %s (grid %d)\n", hipGetErrorString(e), grid);
}
```

```cpp
#include <hip/hip_runtime.h>
#include <hip/hip_cooperative_groups.h>
#include <cstdio>
#include <cstdint>
namespace cg = cooperative_groups;

typedef unsigned short bf16_t;
typedef short bf16x8 __attribute__((ext_vector_type(8)));
typedef float f32x16 __attribute__((ext_vector_type(16)));
typedef float f32x4 __attribute__((ext_vector_type(4)));
typedef unsigned u32x4 __attribute__((ext_vector_type(4)));
typedef unsigned u32x2 __attribute__((ext_vector_type(2)));

constexpr int NB = 4, SEQ = 4096, T = NB * SEQ, DM = 2048;
constexpr int CH = 64, NCH = SEQ / CH;
constexpr int RH = 8, RD = 128;
constexpr int MH = 8, NOPE = 128, ROPE = 64, MDV = 128, QKD = NOPE + ROPE;
constexpr int QR = 768, KVR = 512;
constexpr int INW = 5440, INWP = 5632;
constexpr int DFF = 8192;
constexpr int C_RQ = 0, C_RK = 1024, C_RV = 2048, C_RG = 3072, C_CQ = 4096, C_CKV = 4864, C_KR = 5376;
constexpr float EPS = 1e-5f;
constexpr float ALPHA = 1.189207115002721f;
constexpr float MLA_SCALE_LOG2E = 0.07216878364870322f * 1.4426950408889634f;
constexpr float RK_SCALE = 0.08838834764831845f;

constexpr size_t MiB = 1u << 20;
constexpr size_t WS_WIN = 1 * MiB;
constexpr size_t WS_WUQ = 23 * MiB;
constexpr size_t WS_WUKV = 26 * MiB;
constexpr size_t WS_WOUT = 28 * MiB;
constexpr size_t WS_WUP = 36 * MiB;
constexpr size_t WS_WDN = 68 * MiB;
constexpr size_t WS_R128 = 100 * MiB;
constexpr size_t WS_R64 = 108 * MiB;
constexpr size_t WS_SSQ = 460 * MiB;
constexpr size_t WS_XB = 113 * MiB;
constexpr size_t WS_SP = 113 * MiB;
constexpr size_t WS_RQ = 177 * MiB, WS_RK = 209 * MiB, WS_RV = 241 * MiB, WS_RG = 273 * MiB;
constexpr size_t WS_MQ = 305 * MiB;
constexpr size_t WS_MKN = 353 * MiB;
constexpr size_t WS_KR = 385 * MiB;
constexpr size_t WS_MV = 387 * MiB;
constexpr size_t WS_CQ = 419 * MiB;
constexpr size_t WS_CKV = 443 * MiB;
constexpr size_t WS_MIX = 448 * MiB;
constexpr size_t WS_X1B = 448 * MiB;
constexpr size_t WS_HDN = 113 * MiB;
constexpr size_t WS_END = 512 * MiB;

constexpr int NTHREADS = 512;
constexpr int LDS_BYTES = 147456;

struct Params {
    const float* x; const int* pos; const float* w_in; const float* q_norm_g; const float* w_uq; const float* kv_norm_g;
    const float* w_uk; const float* w_uv; const float* ret_gn_g; const float* w_out; const float* ln1_g; const float* ln1_b;
    const float* w_up; const float* w_down; const float* ln2_g; const float* ln2_b;
    float* out; unsigned char* ws;
    int ph_lo, ph_hi;
};

__device__ __forceinline__ unsigned f2bf(float f) { unsigned u = __float_as_uint(f); return (u + 0x7fffu + ((u >> 16) & 1u)) >> 16; }
__device__ __forceinline__ float bf2f(unsigned v) { return __uint_as_float(v << 16); }
__device__ __forceinline__ unsigned pk2(float lo, float hi) { return f2bf(lo) | (f2bf(hi) << 16); }
__device__ __forceinline__ int crow(int r, int hi) { return (r & 3) + 8 * (r >> 2) + 4 * hi; }
__device__ __forceinline__ float wave_sum(float v) {
#pragma unroll
    for (int o = 1; o < 64; o <<= 1) v += __shfl_xor(v, o);
    return v;
}
__device__ __forceinline__ float wave_max(float v) {
#pragma unroll
    for (int o = 1; o < 64; o <<= 1) v = fmaxf(v, __shfl_xor(v, o));
    return v;
}

__device__ __forceinline__ int d128(int p) { return 64 * ((p >> 2) & 1) + 16 * (p >> 5) + 4 * ((p >> 3) & 3) + (p & 3); }
__device__ __forceinline__ int d64(int p) { return 32 * ((p >> 2) & 1) + 16 * (p >> 5) + 4 * ((p >> 3) & 3) + (p & 3); }
template <int MODE> __device__ __forceinline__ int src_col(int r) {
    if (MODE == 1) {
        if (r < C_RV) return (r & ~127) + d128(r & 127);
        if (r < C_KR) return r;
        if (r < INW) return C_KR + d64(r - C_KR);
        return -1;
    } else if (MODE == 2) {
        if (r < MH * NOPE) return (r >> 7) * QKD + (r & 127);
        const int rr = r - MH * NOPE; return (rr >> 6) * QKD + NOPE + d64(rr & 63);
    }
    return r;
}
template <int MODE>
__device__ __forceinline__ void prep_wt(const float* W, int K, int N, int Npad, bf16_t* Wt, int row_off, const float* kg, float sall, int slo, int shi, float sr, float* lds) {
    const int tid = threadIdx.x;
    const int nkt = K / 64, nnt = Npad / 64;
    for (int it = blockIdx.x; it < nkt * nnt; it += gridDim.x) {
        const int kt = it / nnt, nt = it % nnt, k0 = kt * 64, n0 = nt * 64;
        __syncthreads();
        for (int e = tid; e < 4096; e += NTHREADS) {
            const int kk = e >> 6, nn = e & 63; const int n = n0 + nn; const int sc = src_col<MODE>(n);
            float v = 0.f;
            if (sc >= 0) { v = W[(size_t)(k0 + kk) * N + sc]; if (kg) v *= kg[k0 + kk]; if (n >= slo && n < shi) v *= sr; v *= sall; }
            lds[kk * 65 + nn] = v;
        }
        __syncthreads();
        for (int e = tid; e < 2048; e += NTHREADS) {
            const int nn = e >> 5, kp = (e & 31) * 2;
            const unsigned w = pk2(lds[kp * 65 + nn], lds[(kp + 1) * 65 + nn]);
            *(unsigned*)(Wt + (size_t)(row_off + n0 + nn) * K + k0 + kp) = w;
        }
    }
}
__device__ __forceinline__ void phase_prep(const Params& p, unsigned char* ldsb) {
    float* lds = (float*)ldsb;
    unsigned char* ws = p.ws;
    prep_wt<1>(p.w_in, DM, INW, INWP, (bf16_t*)(ws + WS_WIN), 0, nullptr, 1.f, C_RK, C_RV, RK_SCALE, lds);
    prep_wt<2>(p.w_uq, QR, MH * QKD, MH * QKD, (bf16_t*)(ws + WS_WUQ), 0, p.q_norm_g, MLA_SCALE_LOG2E, 0, 0, 1.f, lds);
    prep_wt<0>(p.w_uk, KVR, MH * NOPE, MH * NOPE, (bf16_t*)(ws + WS_WUKV), 0, p.kv_norm_g, 1.f, 0, 0, 1.f, lds);
    prep_wt<0>(p.w_uv, KVR, MH * MDV, MH * MDV, (bf16_t*)(ws + WS_WUKV), MH * NOPE, p.kv_norm_g, 1.f, 0, 0, 1.f, lds);
    prep_wt<0>(p.w_out, DM, DM, DM, (bf16_t*)(ws + WS_WOUT), 0, nullptr, 1.f, 0, 0, 1.f, lds);
    prep_wt<0>(p.w_up, DM, DFF, DFF, (bf16_t*)(ws + WS_WUP), 0, nullptr, 1.f, 0, 0, 1.f, lds);
    prep_wt<0>(p.w_down, DFF, DM, DM, (bf16_t*)(ws + WS_WDN), 0, nullptr, 1.f, 0, 0, 1.f, lds);
    const size_t gtid = (size_t)blockIdx.x * NTHREADS + threadIdx.x, gsz = (size_t)gridDim.x * NTHREADS;
    bf16_t* xb = (bf16_t*)(ws + WS_XB);
    for (size_t i = gtid; i < (size_t)T * DM / 8; i += gsz) {
        const f32x4 a = *(const f32x4*)(p.x + i * 8), b = *(const f32x4*)(p.x + i * 8 + 4);
        u32x4 w; w.x = pk2(a.x, a.y); w.y = pk2(a.z, a.w); w.z = pk2(b.x, b.y); w.w = pk2(b.z, b.w);
        *(u32x4*)(xb + i * 8) = w;
    }
    float2* r128 = (float2*)(ws + WS_R128); float2* r64 = (float2*)(ws + WS_R64);
    for (size_t i = gtid; i < (size_t)T * 64; i += gsz) {
        const int t = (int)(i >> 6), f = (int)(i & 63);
        const float inv = powf(10000.f, -(float)(2 * f) / 128.f);
        const float ang = (float)p.pos[t] * inv;
        r128[i] = make_float2(cosf(ang), sinf(ang));
    }
    for (size_t i = gtid; i < (size_t)T * 32; i += gsz) {
        const int t = (int)(i >> 5), f = (int)(i & 31);
        const float inv = powf(10000.f, -(float)(2 * f) / 64.f);
        const float ang = (float)p.pos[t] * inv;
        r64[i] = make_float2(cosf(ang), sinf(ang));
    }
}

namespace pg8 {
#define PG8_LAS __attribute__((address_space(3)))
constexpr int BM = 256, BK = 64, HALF = 128, HTB = HALF * BK * 2  , STAGE_BYTES = 8 * HTB, NXCD = 8, WGM = 8;

__host__ __device__ __forceinline__ int lds_byte(int r, int c) { const int st = (r >> 4) * 2 + (c >> 5), rr = r & 15, cc = c & 31, ob = rr * 64 + cc * 2; return st * 1024 + (ob ^ (((ob >> 9) & 1) << 5)); }
__host__ __device__ __forceinline__ void stage_rc(int b, int& R, int& C) { const int st = b / 1024, sb = b % 1024, swz = sb ^ (((sb >> 9) & 1) << 5); R = (st >> 1) * 16 + swz / 64; C = (st & 1) * 32 + (swz % 64) / 2; }
__host__ __device__ __forceinline__ int perm32(int rho) { const int n = rho >> 4, i = rho & 15; return 8 * (i >> 2) + 4 * n + (i & 3); }

struct Unit { int pm, pn; };
struct Gemm { const bf16_t* A; const bf16_t* Bt; int M, N, K; };

struct StaticOrder {
    int nM, nN, nwg, G, c;
    __host__ __device__ void init(int M, int N, int G_, int c_) { nM = M / BM; nN = N / BM; nwg = nM * nN; G = G_; c = c_; }
    __host__ __device__ bool next(int i, Unit& u) const {
        const long L = (long)i * G + c; if (L >= nwg) return false;
        int wgid = (int)L; { const int q = nwg / NXCD, r = nwg % NXCD, xcd = wgid % NXCD, off = wgid / NXCD; wgid = (xcd < r ? xcd * (q + 1) : r * (q + 1) + (xcd - r) * q) + off; }
        const int nig = WGM * nN, gid = wgid / nig, fm = gid * WGM, gsz = (nM - fm) < WGM ? (nM - fm) : WGM;
        u.pm = fm + ((wgid % nig) % gsz); u.pn = (wgid % nig) / gsz; return true;
    }
    __device__ __forceinline__ void a_ready(const Unit&) const {}
    __device__ __forceinline__ void done(const Unit&) const {}
};

__device__ __forceinline__ unsigned cvt_pk_bf16(float lo, float hi) { unsigned r; asm volatile("v_cvt_pk_bf16_f32 %0, %1, %2" : "=v"(r) : "v"(lo), "v"(hi)); return r; }
__device__ __forceinline__ u32x4 pack8(f32x4 v0, f32x4 v1) { u32x4 w; w.x = cvt_pk_bf16(v0[0], v0[1]); w.y = cvt_pk_bf16(v0[2], v0[3]); w.z = cvt_pk_bf16(v1[0], v1[1]); w.w = cvt_pk_bf16(v1[2], v1[3]); return w; }

struct EpiProj {
    static constexpr bool PERM = true, AFTER_DRAIN = false;
    unsigned char* ws;
    __device__ __forceinline__ void operator()(const f32x4 (&acc)[2][2][4][2], const Unit& u, int wr, int wc, int fr, int fq) const {
        const int row0 = u.pm * BM + wr * 64 + fr, pn = u.pn;
        if (pn < 8) {
            const float* r128 = (const float*)(ws + WS_R128);
            bf16_t* dst = (bf16_t*)(ws + (pn < 4 ? WS_RQ : WS_RK)) + (size_t)((pn & 3) * BM + wc * 32 + 8 * fq);
#pragma unroll
            for (int ai = 0; ai < 2; ++ai)
#pragma unroll
                for (int m = 0; m < 4; ++m) { const int row = row0 + ai * HALF + m * 16;
                    const float* tp = r128 + ((size_t)row * 64 + 16 * wc + 4 * fq) * 2; const f32x4 t0 = *(const f32x4*)tp, t1 = *(const f32x4*)(tp + 4);
                    const f32x4 c = {t0[0], t0[2], t1[0], t1[2]}, sn = {t0[1], t0[3], t1[1], t1[3]};
#pragma unroll
                    for (int bj = 0; bj < 2; ++bj) { const f32x4 x1 = acc[ai][bj][m][0], x2 = acc[ai][bj][m][1];
                        *(u32x4*)(dst + (size_t)row * 1024 + bj * HALF) = pack8(x1 * c - x2 * sn, x1 * sn + x2 * c); } }
        } else if (pn < 21) {
            size_t wo; int ld, cb;
            if (pn < 12) { wo = WS_RV; ld = 1024; cb = (pn - 8) * BM; } else if (pn < 16) { wo = WS_RG; ld = 1024; cb = (pn - 12) * BM; }
            else if (pn < 19) { wo = WS_CQ; ld = QR; cb = (pn - 16) * BM; } else { wo = WS_CKV; ld = KVR; cb = (pn - 19) * BM; }
            bf16_t* dst = (bf16_t*)(ws + wo) + cb + wc * 32 + 8 * fq;
            float* ssq = (float*)(ws + WS_SSQ);
#pragma unroll
            for (int ai = 0; ai < 2; ++ai)
#pragma unroll
                for (int m = 0; m < 4; ++m) { const int row = row0 + ai * HALF + m * 16;
#pragma unroll
                    for (int bj = 0; bj < 2; ++bj) *(u32x4*)(dst + (size_t)row * ld + bj * HALF) = pack8(acc[ai][bj][m][0], acc[ai][bj][m][1]);
                    if (pn >= 16) {
                        float sq = 0.f;
#pragma unroll
                        for (int bj = 0; bj < 2; ++bj)
#pragma unroll
                            for (int n = 0; n < 2; ++n) { const f32x4 v = acc[ai][bj][m][n]; sq += (v[0] * v[0] + v[1] * v[1]) + (v[2] * v[2] + v[3] * v[3]); }
                        sq += __shfl_xor(sq, 16); sq += __shfl_xor(sq, 32);
                        if (fq == 0) ssq[(size_t)row * 20 + (pn - 16) * 4 + wc] = sq; } }
        } else if (wc < 2) {
            const float* r64 = (const float*)(ws + WS_R64); bf16_t* kr = (bf16_t*)(ws + WS_KR);
#pragma unroll
            for (int ai = 0; ai < 2; ++ai)
#pragma unroll
                for (int m = 0; m < 4; ++m) { const int row = row0 + ai * HALF + m * 16;
                    const float* tp = r64 + ((size_t)row * 32 + 16 * wc + 4 * fq) * 2; const f32x4 t0 = *(const f32x4*)tp, t1 = *(const f32x4*)(tp + 4);
                    const f32x4 c = {t0[0], t0[2], t1[0], t1[2]}, sn = {t0[1], t0[3], t1[1], t1[3]};
                    const f32x4 x1 = acc[ai][0][m][0], x2 = acc[ai][0][m][1];
                    *(u32x4*)(kr + (size_t)row * 64 + wc * 32 + 8 * fq) = pack8(x1 * c - x2 * sn, x1 * sn + x2 * c); }
        }
    }
};
struct EpiQ {
    static constexpr bool PERM = true, AFTER_DRAIN = false;
    bf16_t* mq; const float* rinv; const float* r64;
    __device__ __forceinline__ void operator()(const f32x4 (&acc)[2][2][4][2], const Unit& u, int wr, int wc, int fr, int fq) const {
        const int row0 = u.pm * BM + wr * 64 + fr, pn = u.pn;
        bf16_t* dst = mq + (size_t)(pn * BM + wc * 32 + 8 * fq);
#pragma unroll
        for (int ai = 0; ai < 2; ++ai)
#pragma unroll
            for (int m = 0; m < 4; ++m) { const int row = row0 + ai * HALF + m * 16;
                const f32x4 s0 = *(const f32x4*)(rinv + (size_t)row * 20), s1 = *(const f32x4*)(rinv + (size_t)row * 20 + 4), s2 = *(const f32x4*)(rinv + (size_t)row * 20 + 8);
                const float s = 1.0f / sqrtf((((s0[0] + s0[1]) + (s0[2] + s0[3])) + ((s1[0] + s1[1]) + (s1[2] + s1[3])) + ((s2[0] + s2[1]) + (s2[2] + s2[3]))) * (1.f / (float)QR) + EPS);
                if (pn < 4) {
#pragma unroll
                    for (int bj = 0; bj < 2; ++bj) *(u32x4*)(dst + (size_t)row * (MH * QKD) + bj * HALF) = pack8(acc[ai][bj][m][0] * s, acc[ai][bj][m][1] * s);
                } else {
                    const float* tp = r64 + ((size_t)row * 32 + 16 * (wc & 1) + 4 * fq) * 2; const f32x4 t0 = *(const f32x4*)tp, t1 = *(const f32x4*)(tp + 4);
                    const f32x4 c = {t0[0], t0[2], t1[0], t1[2]}, sn = {t0[1], t0[3], t1[1], t1[3]};
#pragma unroll
                    for (int bj = 0; bj < 2; ++bj) { const f32x4 x1 = acc[ai][bj][m][0] * s, x2 = acc[ai][bj][m][1] * s;
                        *(u32x4*)(dst + (size_t)row * (MH * QKD) + bj * HALF) = pack8(x1 * c - x2 * sn, x1 * sn + x2 * c); }
                } }
    }
};
struct EpiKV {
    static constexpr bool PERM = true, AFTER_DRAIN = false;
    unsigned char* ws; const float* rinv;
    __device__ __forceinline__ void operator()(const f32x4 (&acc)[2][2][4][2], const Unit& u, int wr, int wc, int fr, int fq) const {
        const int row0 = u.pm * BM + wr * 64 + fr, pn = u.pn;
        bf16_t* dst = (bf16_t*)(ws + (pn < 4 ? WS_MKN : WS_MV)) + (size_t)((pn & 3) * BM + wc * 32 + 8 * fq);
#pragma unroll
        for (int ai = 0; ai < 2; ++ai)
#pragma unroll
            for (int m = 0; m < 4; ++m) { const int row = row0 + ai * HALF + m * 16;
                const f32x4 s0 = *(const f32x4*)(rinv + (size_t)row * 20 + 12), s1 = *(const f32x4*)(rinv + (size_t)row * 20 + 16);
                const float s = 1.0f / sqrtf((((s0[0] + s0[1]) + (s0[2] + s0[3])) + ((s1[0] + s1[1]) + (s1[2] + s1[3]))) * (1.f / (float)KVR) + EPS);
#pragma unroll
                for (int bj = 0; bj < 2; ++bj) *(u32x4*)(dst + (size_t)row * 1024 + bj * HALF) = pack8(acc[ai][bj][m][0] * s, acc[ai][bj][m][1] * s); }
    }
};
struct EpiResF32 {
    static constexpr bool PERM = false, AFTER_DRAIN = false;
    const float* base; float* y;
    __device__ __forceinline__ void operator()(const f32x4 (&acc)[2][2][4][2], const Unit& u, int wr, int wc, int fr, int fq) const {
        const int row0 = u.pm * BM + wr * 64 + fr, col0 = u.pn * BM + wc * 32 + 4 * fq;
#pragma unroll
        for (int ai = 0; ai < 2; ++ai)
#pragma unroll
            for (int m = 0; m < 4; ++m) { const size_t off = (size_t)(row0 + ai * HALF + m * 16) * DM + col0;
#pragma unroll
                for (int bj = 0; bj < 2; ++bj)
#pragma unroll
                    for (int n = 0; n < 2; ++n) { const f32x4 b = *(const f32x4*)(base + off + bj * HALF + n * 16); *(f32x4*)(y + off + bj * HALF + n * 16) = b * ALPHA + acc[ai][bj][m][n]; } }
    }
};
struct EpiRelu2 {
    static constexpr bool PERM = true, AFTER_DRAIN = false;
    bf16_t* h;
    __device__ __forceinline__ void operator()(const f32x4 (&acc)[2][2][4][2], const Unit& u, int wr, int wc, int fr, int fq) const {
        const int row0 = u.pm * BM + wr * 64 + fr;
        bf16_t* dst = h + (size_t)(u.pn * BM + wc * 32 + 8 * fq);
        const f32x4 z = {0.f, 0.f, 0.f, 0.f};
#pragma unroll
        for (int ai = 0; ai < 2; ++ai)
#pragma unroll
            for (int m = 0; m < 4; ++m) { const int row = row0 + ai * HALF + m * 16;
#pragma unroll
                for (int bj = 0; bj < 2; ++bj) { const f32x4 a = __builtin_elementwise_max(acc[ai][bj][m][0], z), b = __builtin_elementwise_max(acc[ai][bj][m][1], z);
                    *(u32x4*)(dst + (size_t)row * DFF + bj * HALF) = pack8(a * a, b * b); } }
    }
};

template <class Epi, class Sched, bool ALIGN_EPI = false, bool SP2 = false>
__device__ __forceinline__ void gemm_phase(PG8_LAS unsigned char* lds, const Gemm g, const Sched& S, const Epi& E) {
    const int tid = threadIdx.x, wid = __builtin_amdgcn_readfirstlane(tid >> 6), lane = tid & 63, wr = wid >> 2, wc = wid & 3, fr = lane & 15, fq = lane >> 4;
    const int K = g.K, nt = K / BK;
    unsigned voffA[2], voffB[2];
#pragma unroll
    for (int i = 0; i < 2; ++i) { int R, C; stage_rc(tid * 16 + i * 8192, R, C); const int Rb = Epi::PERM ? ((R & ~31) + perm32(R & 31)) : R;
        voffA[i] = (unsigned)(R * K + C) * 2u; voffB[i] = (unsigned)(Rb * K + C) * 2u; }
    const size_t kstep = (size_t)(BK * 2);
    const size_t hstep = (size_t)HALF * K * 2;
    const size_t tstep = 2 * hstep;
    const unsigned ldsw = (unsigned)wid * 1024u;
    const int aoff = lds_byte(wr * 64 + fr, fq * 8), boff = lds_byte(wc * 32 + fr, fq * 8);
#define PG8_SA(b, h) (((b) * 2 + (h)) * HTB)
#define PG8_SB(b, h) ((4 + (b) * 2 + (h)) * HTB)
#define PG8_STAGE(bufoff, gbase, voff) do { _Pragma("unroll") for (int _i = 0; _i < 2; ++_i) \
        __builtin_amdgcn_global_load_lds((const unsigned*)((const char*)(gbase) + (voff)[_i]), (PG8_LAS unsigned*)(lds + (bufoff) + ldsw + _i * 8192), 16, 0, 0); } while (0)
#define PG8_LDA(dst, b, h) do { _Pragma("unroll") for (int m = 0; m < 4; ++m) _Pragma("unroll") for (int k = 0; k < 2; ++k) dst[m][k] = *(const PG8_LAS bf16x8*)(lds + PG8_SA(b, h) + aoff + m * 2048 + k * 1024); } while (0)
#define PG8_LDB(dst, b, h) do { _Pragma("unroll") for (int n = 0; n < 2; ++n) _Pragma("unroll") for (int k = 0; k < 2; ++k) dst[n][k] = *(const PG8_LAS bf16x8*)(lds + PG8_SB(b, h) + boff + n * 2048 + k * 1024); } while (0)
#define PG8_MMA(ai, bj, At, Bt) do { __builtin_amdgcn_s_setprio(1); _Pragma("unroll") for (int m = 0; m < 4; ++m) _Pragma("unroll") for (int n = 0; n < 2; ++n) _Pragma("unroll") for (int k = 0; k < 2; ++k) \
        acc[ai][bj][m][n] = __builtin_amdgcn_mfma_f32_16x16x32_bf16(Bt[n][k], At[m][k], acc[ai][bj][m][n], 0, 0, 0); __builtin_amdgcn_s_setprio(0); } while (0)
#define PG8_WAIT_V(n) asm volatile("s_waitcnt vmcnt(" #n ")" ::: "memory")
#define PG8_WAIT_L(n) asm volatile("s_waitcnt lgkmcnt(" #n ")" ::: "memory")
#define PG8_BAR __builtin_amdgcn_s_barrier()
#define PG8_SCHED __builtin_amdgcn_sched_barrier(0)
    Unit cur, nxt; int ui = 0;
    if (!S.next(0, cur)) return;
    f32x4 acc[2][2][4][2];
#pragma unroll
    for (int a = 0; a < 2; ++a)
#pragma unroll
        for (int b = 0; b < 2; ++b)
#pragma unroll
            for (int m = 0; m < 4; ++m)
#pragma unroll
                for (int n = 0; n < 2; ++n) acc[a][b][m][n] = (f32x4){0.f, 0.f, 0.f, 0.f};
    bf16x8 At[4][2], B0[2][2], B1[2][2];
    const char* cA = (const char*)g.A + (size_t)cur.pm * tstep; const char* cB = (const char*)g.Bt + (size_t)cur.pn * tstep;
    S.a_ready(cur);
    if constexpr (SP2) {
        PG8_STAGE(PG8_SB(0, 0), cB, voffB); PG8_STAGE(PG8_SB(0, 1), cB + hstep, voffB); PG8_STAGE(PG8_SA(0, 0), cA, voffA); PG8_STAGE(PG8_SA(0, 1), cA + hstep, voffA);
        if (wr == 1) PG8_BAR;
        PG8_WAIT_V(2); PG8_BAR;
        PG8_STAGE(PG8_SB(1, 0), cB + kstep, voffB); PG8_STAGE(PG8_SA(1, 0), cA + kstep, voffA); PG8_STAGE(PG8_SB(1, 1), cB + hstep + kstep, voffB);
        PG8_WAIT_V(6); PG8_BAR;
    } else {
        PG8_STAGE(PG8_SB(0, 0), cB, voffB); PG8_STAGE(PG8_SA(0, 0), cA, voffA); PG8_STAGE(PG8_SB(0, 1), cB + hstep, voffB); PG8_STAGE(PG8_SA(0, 1), cA + hstep, voffA);
        if (wr == 1) PG8_BAR;
        PG8_WAIT_V(4); PG8_BAR;
        PG8_STAGE(PG8_SB(1, 0), cB + kstep, voffB); PG8_STAGE(PG8_SA(1, 0), cA + kstep, voffA); PG8_STAGE(PG8_SB(1, 1), cB + hstep + kstep, voffB);
        PG8_WAIT_V(6); PG8_BAR;
    }
    for (;;) {
        const bool has_next = S.next(ui + 1, nxt);
        const char* nA = has_next ? (const char*)g.A + (size_t)nxt.pm * tstep : cA; const char* nB = has_next ? (const char*)g.Bt + (size_t)nxt.pn * tstep : cB;
        for (int t = 0; t < nt; t += 2) {
            const bool last = (t == nt - 2);
            const char* a1 = cA + (size_t)(t + 1) * kstep;
            const char* a2 = last ? nA : cA + (size_t)(t + 2) * kstep; const char* b2 = last ? nB : cB + (size_t)(t + 2) * kstep;
            const char* a3 = a2 + kstep; const char* b3 = b2 + kstep;
            if (last && has_next) S.a_ready(nxt);
            if constexpr (SP2) {
            PG8_LDB(B0, 0, 0); PG8_LDB(B1, 0, 1); PG8_SCHED; PG8_LDA(At, 0, 0); PG8_STAGE(PG8_SA(1, 1), a1 + hstep, voffA);
            PG8_WAIT_V(8); PG8_WAIT_L(0); PG8_BAR; PG8_MMA(0, 0, At, B0); PG8_MMA(0, 1, At, B1); PG8_BAR; PG8_SCHED;
            PG8_LDA(At, 0, 1); PG8_STAGE(PG8_SB(0, 0), b2, voffB); PG8_STAGE(PG8_SB(0, 1), b2 + hstep, voffB); PG8_STAGE(PG8_SA(0, 0), a2, voffA);
            PG8_WAIT_V(8); PG8_WAIT_L(0); PG8_BAR; PG8_MMA(1, 0, At, B0); PG8_MMA(1, 1, At, B1); PG8_BAR; PG8_SCHED;
            PG8_LDB(B0, 1, 0); PG8_LDB(B1, 1, 1); PG8_SCHED; PG8_LDA(At, 1, 0); PG8_STAGE(PG8_SA(0, 1), a2 + hstep, voffA);
            PG8_WAIT_V(8); PG8_WAIT_L(0); PG8_BAR; PG8_MMA(0, 0, At, B0); PG8_MMA(0, 1, At, B1); PG8_BAR; PG8_SCHED;
            PG8_LDA(At, 1, 1); PG8_STAGE(PG8_SB(1, 0), b3, voffB); PG8_STAGE(PG8_SB(1, 1), b3 + hstep, voffB); PG8_STAGE(PG8_SA(1, 0), a3, voffA);
            PG8_WAIT_V(8); PG8_WAIT_L(0); PG8_BAR; PG8_MMA(1, 0, At, B0); PG8_MMA(1, 1, At, B1); PG8_BAR; PG8_SCHED;
            } else {
            PG8_LDB(B0, 0, 0); PG8_SCHED; PG8_LDA(At, 0, 0); PG8_STAGE(PG8_SA(1, 1), a1 + hstep, voffA);
            PG8_WAIT_L(8); PG8_BAR; PG8_WAIT_L(0); PG8_MMA(0, 0, At, B0); PG8_BAR; PG8_SCHED;
            PG8_LDB(B1, 0, 1); PG8_STAGE(PG8_SB(0, 0), b2, voffB);
            PG8_BAR; PG8_WAIT_L(0); PG8_MMA(0, 1, At, B1); PG8_BAR;
            PG8_LDA(At, 0, 1); PG8_STAGE(PG8_SA(0, 0), a2, voffA);
            PG8_BAR; PG8_WAIT_L(0); PG8_MMA(1, 0, At, B0); PG8_BAR; PG8_SCHED;
            PG8_STAGE(PG8_SB(0, 1), b2 + hstep, voffB);
            PG8_WAIT_V(6); PG8_BAR; PG8_MMA(1, 1, At, B1); PG8_BAR;
            PG8_LDB(B0, 1, 0); PG8_SCHED; PG8_LDA(At, 1, 0); PG8_STAGE(PG8_SA(0, 1), a2 + hstep, voffA);
            PG8_WAIT_L(8); PG8_BAR; PG8_WAIT_L(0); PG8_MMA(0, 0, At, B0); PG8_BAR; PG8_SCHED;
            PG8_LDB(B1, 1, 1); PG8_STAGE(PG8_SB(1, 0), b3, voffB);
            PG8_BAR; PG8_WAIT_L(0); PG8_MMA(0, 1, At, B1); PG8_BAR;
            PG8_LDA(At, 1, 1); PG8_STAGE(PG8_SA(1, 0), a3, voffA);
            PG8_BAR; PG8_WAIT_L(0); PG8_MMA(1, 0, At, B0); PG8_BAR; PG8_SCHED;
            PG8_STAGE(PG8_SB(1, 1), b3 + hstep, voffB);
            PG8_WAIT_V(6); PG8_BAR; PG8_MMA(1, 1, At, B1); PG8_BAR;
            }
        }
        if constexpr (ALIGN_EPI) { if (wr == 0) PG8_BAR; }
        if constexpr (!Epi::AFTER_DRAIN) { E(acc, cur, wr, wc, fr, fq); S.done(cur); }
        if (!has_next) break;
#pragma unroll
        for (int a = 0; a < 2; ++a)
#pragma unroll
            for (int b = 0; b < 2; ++b)
#pragma unroll
                for (int m = 0; m < 4; ++m)
#pragma unroll
                    for (int n = 0; n < 2; ++n) acc[a][b][m][n] = (f32x4){0.f, 0.f, 0.f, 0.f};
        cur = nxt; cA = nA; cB = nB; ++ui;
        if constexpr (ALIGN_EPI) { if (wr == 1) PG8_BAR; }
    }
    PG8_WAIT_V(0);
    if constexpr (!ALIGN_EPI) { if (wr == 0) PG8_BAR; }
    PG8_BAR;
    if constexpr (Epi::AFTER_DRAIN) { E.fused(acc, cur, wr, wc, fr, fq, lds, wid, lane); S.done(cur); }
#undef PG8_SA
#undef PG8_SB
#undef PG8_STAGE
#undef PG8_LDA
#undef PG8_LDB
#undef PG8_MMA
#undef PG8_WAIT_V
#undef PG8_WAIT_L
#undef PG8_BAR
#undef PG8_SCHED
}
}

namespace ret {
typedef __attribute__((address_space(3))) unsigned char* lptr;
typedef short s16x4 __attribute__((ext_vector_type(4)));
typedef float f32x2_t __attribute__((ext_vector_type(2))); typedef __bf16 bf16x2_t __attribute__((ext_vector_type(2)));
__device__ __forceinline__ unsigned cvtpk_s(float lo, float hi) { f32x2_t v = {lo, hi}; bf16x2_t b = __builtin_convertvector(v, bf16x2_t); return __builtin_bit_cast(unsigned, b); }
__device__ __forceinline__ s16x4 vtr(lptr p) { return __builtin_bit_cast(s16x4, __builtin_amdgcn_ds_read_tr16_b64_v4i16((__attribute__((address_space(3))) s16x4*)p)); }
__device__ __forceinline__ bf16x8 cat8(s16x4 lo, s16x4 hi) { return (bf16x8){lo[0], lo[1], lo[2], lo[3], hi[0], hi[1], hi[2], hi[3]}; }
__device__ __forceinline__ u32x4 scale8(u32x4 w, float s) {
    u32x4 o;
    o.x = cvtpk_s(bf2f(w.x & 0xffffu) * s, bf2f(w.x >> 16) * s); o.y = cvtpk_s(bf2f(w.y & 0xffffu) * s, bf2f(w.y >> 16) * s);
    o.z = cvtpk_s(bf2f(w.z & 0xffffu) * s, bf2f(w.z >> 16) * s); o.w = cvtpk_s(bf2f(w.w & 0xffffu) * s, bf2f(w.w >> 16) * s); return o;
}
__device__ __forceinline__ float logg(int h) { return log1pf(-exp2f(-5.0f - (float)h)); }

constexpr int KT_RS = 320, VT_RS = 192, KT_OFF = 0, VT_OFF = 64 * KT_RS, SPT_OFF = VT_OFF + 64 * VT_RS, SPT_RS = 256, SCAN_LDS = SPT_OFF + 64 * SPT_RS;
__device__ __forceinline__ void scan_item(lptr lds, const bf16_t* RK, const bf16_t* RV, bf16_t* SP, int bh, int eh) {
    const int tid = threadIdx.x, wid = __builtin_amdgcn_readfirstlane(tid >> 6), lane = tid & 63, r32 = lane & 31, hi = lane >> 5;
    const int g1 = (lane >> 4) & 1, q = (lane & 15) >> 2, pq = lane & 3;
    const int b = bh / RH, h = bh % RH, eb2 = wid >> 2, db = wid & 3;
    const float lg = logg(h), cd = expf(64.f * lg);
    const int kr0 = tid >> 4, kc = tid & 15, vr = tid >> 3, vc = tid & 7;
    const float dk0 = expf(lg * (float)(63 - kr0)), dk1 = expf(lg * (float)(63 - (kr0 + 32)));
    const bf16_t* kg = RK + ((size_t)b * SEQ + kr0) * 1024 + h * 128 + kc * 8;
    const bf16_t* vg = RV + ((size_t)b * SEQ + vr) * 1024 + h * 128 + eh * 64 + vc * 8;
    lptr kw = lds + KT_OFF + kr0 * KT_RS + kc * 16, vw = lds + VT_OFF + vr * VT_RS + vc * 16;
    lptr ar = lds + VT_OFF + (8 * hi + q) * VT_RS + (32 * eb2 + 16 * g1 + 4 * pq) * 2;
    lptr br = lds + KT_OFF + (8 * hi + q) * KT_RS + (32 * db + 16 * g1 + 4 * pq) * 2;
    f32x16 acc;
#pragma unroll
    for (int r = 0; r < 16; ++r) acc[r] = 0.f;
    u32x4 k0 = *(const u32x4*)kg, k1 = *(const u32x4*)(kg + 32 * 1024), v0 = *(const u32x4*)vg;
    __syncthreads();
    *(__attribute__((address_space(3))) u32x4*)kw = scale8(k0, dk0); *(__attribute__((address_space(3))) u32x4*)(kw + 32 * KT_RS) = scale8(k1, dk1); *(__attribute__((address_space(3))) u32x4*)vw = v0;
    k0 = *(const u32x4*)(kg + 64 * 1024); k1 = *(const u32x4*)(kg + 96 * 1024); v0 = *(const u32x4*)(vg + 64 * 1024);
    __syncthreads();
    bf16_t* spg = SP + ((size_t)bh * NCH * 128 + eh * 64) * 128;
    for (int n = 0; n < NCH; ++n) {
#pragma unroll
        for (int r = 0; r < 16; ++r) *(__attribute__((address_space(3))) bf16_t*)(lds + SPT_OFF + (32 * eb2 + crow(r, hi)) * SPT_RS + (32 * db + r32) * 2) = (bf16_t)f2bf(acc[r]);
#pragma unroll
        for (int r = 0; r < 16; ++r) acc[r] *= cd;
#pragma unroll
        for (int ks = 0; ks < 4; ++ks) {
            const bf16x8 a = cat8(vtr(ar + (16 * ks) * VT_RS), vtr(ar + (16 * ks + 4) * VT_RS));
            const bf16x8 bq = cat8(vtr(br + (16 * ks) * KT_RS), vtr(br + (16 * ks + 4) * KT_RS));
            acc = __builtin_amdgcn_mfma_f32_32x32x16_bf16(a, bq, acc, 0, 0, 0);
        }
        __syncthreads();
        { bf16_t* dst = spg + (size_t)n * 128 * 128;
#pragma unroll
          for (int i = 0; i < 2; ++i) { const int c = tid + 512 * i, e = c >> 4, ch = c & 15;
              *(u32x4*)(dst + (size_t)e * 128 + ch * 8) = *(const __attribute__((address_space(3))) u32x4*)(lds + SPT_OFF + e * SPT_RS + ch * 16); } }
        if (n + 1 < NCH) {
            *(__attribute__((address_space(3))) u32x4*)kw = scale8(k0, dk0); *(__attribute__((address_space(3))) u32x4*)(kw + 32 * KT_RS) = scale8(k1, dk1); *(__attribute__((address_space(3))) u32x4*)vw = v0;
            if (n + 2 < NCH) { const size_t o = (size_t)(n + 2) * 64 * 1024; k0 = *(const u32x4*)(kg + o); k1 = *(const u32x4*)(kg + o + 32 * 1024); v0 = *(const u32x4*)(vg + o); }
        }
        __syncthreads();
    }
}

constexpr int QK_RS = 272, V_RS = 320, OQ_OFF = 0, OK_OFF = 64 * QK_RS, OV_OFF = 2 * 64 * QK_RS, OO_OFF = OV_OFF + 64 * V_RS, OO_LD = 132, OUT_LDS = OO_OFF + 64 * OO_LD * 4;
__device__ __forceinline__ void out_item(lptr lds, const bf16_t* RQ, const bf16_t* RK, const bf16_t* RV, const bf16_t* RG, const bf16_t* SP, const float* gn_g, bf16_t* MIX, int it) {
    const int tid = threadIdx.x, wid = __builtin_amdgcn_readfirstlane(tid >> 6), lane = tid & 63, r32 = lane & 31, hi = lane >> 5;
    const int g1 = (lane >> 4) & 1, q = (lane & 15) >> 2, pq = lane & 3;
    const int bh = it / NCH, n = it % NCH, b = bh / RH, h = bh % RH, ib = wid >> 2, eb = wid & 3;
    const float lg2 = logg(h) * 1.4426950408889634f;
    const size_t t0 = (size_t)b * SEQ + (size_t)n * CH;
    {
        const int r0 = tid >> 4, c16 = tid & 15; const size_t go = (t0 + r0) * 1024 + h * 128 + c16 * 8;
        const u32x4 q0 = *(const u32x4*)(RQ + go), q1 = *(const u32x4*)(RQ + go + 32 * 1024), k0 = *(const u32x4*)(RK + go), k1 = *(const u32x4*)(RK + go + 32 * 1024),
                    v0 = *(const u32x4*)(RV + go), v1 = *(const u32x4*)(RV + go + 32 * 1024);
        __syncthreads();
        *(__attribute__((address_space(3))) u32x4*)(lds + OQ_OFF + r0 * QK_RS + c16 * 16) = q0; *(__attribute__((address_space(3))) u32x4*)(lds + OQ_OFF + (r0 + 32) * QK_RS + c16 * 16) = q1;
        *(__attribute__((address_space(3))) u32x4*)(lds + OK_OFF + r0 * QK_RS + c16 * 16) = k0; *(__attribute__((address_space(3))) u32x4*)(lds + OK_OFF + (r0 + 32) * QK_RS + c16 * 16) = k1;
        *(__attribute__((address_space(3))) u32x4*)(lds + OV_OFF + r0 * V_RS + c16 * 16) = v0; *(__attribute__((address_space(3))) u32x4*)(lds + OV_OFF + (r0 + 32) * V_RS + c16 * 16) = v1;
        __syncthreads();
    }
    f32x16 acc;
#pragma unroll
    for (int r = 0; r < 16; ++r) acc[r] = 0.f;
    lptr qa = lds + OQ_OFF + (32 * ib + r32) * QK_RS + hi * 16;
    const bf16_t* spb = SP + ((size_t)it * 128 + 32 * eb + r32) * 128 + hi * 8;
#pragma unroll
    for (int ks = 0; ks < 8; ++ks) {
        const bf16x8 a = *(const __attribute__((address_space(3))) bf16x8*)(qa + ks * 32);
        const bf16x8 bq = *(const bf16x8*)(spb + ks * 16);
        acc = __builtin_amdgcn_mfma_f32_32x32x16_bf16(a, bq, acc, 0, 0, 0);
    }
#pragma unroll
    for (int r = 0; r < 16; ++r) acc[r] *= __builtin_amdgcn_exp2f(lg2 * (float)(32 * ib + crow(r, hi) + 1));
    lptr vbase = lds + OV_OFF + (4 * hi + q) * V_RS + (32 * eb + 16 * g1 + 4 * pq) * 2;
#pragma unroll
    for (int jb = 0; jb < 2; ++jb) {
        f32x16 x;
#pragma unroll
        for (int r = 0; r < 16; ++r) x[r] = 0.f;
        lptr ka = lds + OK_OFF + (32 * jb + r32) * QK_RS + hi * 16;
#pragma unroll
        for (int ks = 0; ks < 8; ++ks) {
            const bf16x8 a = *(const __attribute__((address_space(3))) bf16x8*)(ka + ks * 32);
            const bf16x8 bq = *(const __attribute__((address_space(3))) bf16x8*)(qa + ks * 32);
            x = __builtin_amdgcn_mfma_f32_32x32x16_bf16(a, bq, x, 0, 0, 0);
        }
        const int iq = 32 * ib + r32;
#pragma unroll
        for (int r = 0; r < 16; ++r) { const int j = 32 * jb + crow(r, hi); const int dist = iq > j ? iq - j : j - iq; x[r] *= __builtin_amdgcn_exp2f(lg2 * (float)dist); }
#pragma unroll
        for (int s = 0; s < 2; ++s) {
            u32x4 w; w.x = cvtpk_s(x[8 * s + 0], x[8 * s + 1]); w.y = cvtpk_s(x[8 * s + 2], x[8 * s + 3]); w.z = cvtpk_s(x[8 * s + 4], x[8 * s + 5]); w.w = cvtpk_s(x[8 * s + 6], x[8 * s + 7]);
            const bf16x8 pa = __builtin_bit_cast(bf16x8, w);
            const bf16x8 vb = cat8(vtr(vbase + (32 * jb + 16 * s) * V_RS), vtr(vbase + (32 * jb + 16 * s + 8) * V_RS));
            acc = __builtin_amdgcn_mfma_f32_32x32x16_bf16(pa, vb, acc, 0, 0, 0);
        }
    }
    __attribute__((address_space(3))) float* oo = (__attribute__((address_space(3))) float*)(lds + OO_OFF);
#pragma unroll
    for (int r = 0; r < 16; ++r) oo[(32 * ib + crow(r, hi)) * OO_LD + 32 * eb + r32] = acc[r];
    __syncthreads();
    {
        const int i = tid >> 3, e0 = (tid & 7) * 16;
        f32x4 v[4]; float s1 = 0.f;
#pragma unroll
        for (int k = 0; k < 4; ++k) { v[k] = *(const __attribute__((address_space(3))) f32x4*)(oo + i * OO_LD + e0 + 4 * k); s1 += (v[k].x + v[k].y) + (v[k].z + v[k].w); }
        s1 += __shfl_xor(s1, 1); s1 += __shfl_xor(s1, 2); s1 += __shfl_xor(s1, 4);
        const float mu = s1 * (1.f / 128.f); float s2 = 0.f;
#pragma unroll
        for (int k = 0; k < 4; ++k) { v[k] = v[k] - mu; s2 += (v[k].x * v[k].x + v[k].y * v[k].y) + (v[k].z * v[k].z + v[k].w * v[k].w); }
        s2 += __shfl_xor(s2, 1); s2 += __shfl_xor(s2, 2); s2 += __shfl_xor(s2, 4);
        const float rstd = 1.0f / sqrtf(s2 * (1.f / 128.f) + EPS);
        const size_t trow = t0 + i; const int c0 = h * 128 + e0;
        const u32x4 gw0 = *(const u32x4*)(RG + trow * 1024 + c0), gw1 = *(const u32x4*)(RG + trow * 1024 + c0 + 8);
        float gt[16];
        gt[0] = bf2f(gw0.x & 0xffffu); gt[1] = bf2f(gw0.x >> 16); gt[2] = bf2f(gw0.y & 0xffffu); gt[3] = bf2f(gw0.y >> 16); gt[4] = bf2f(gw0.z & 0xffffu); gt[5] = bf2f(gw0.z >> 16); gt[6] = bf2f(gw0.w & 0xffffu); gt[7] = bf2f(gw0.w >> 16);
        gt[8] = bf2f(gw1.x & 0xffffu); gt[9] = bf2f(gw1.x >> 16); gt[10] = bf2f(gw1.y & 0xffffu); gt[11] = bf2f(gw1.y >> 16); gt[12] = bf2f(gw1.z & 0xffffu); gt[13] = bf2f(gw1.z >> 16); gt[14] = bf2f(gw1.w & 0xffffu); gt[15] = bf2f(gw1.w >> 16);
        float ov[16];
#pragma unroll
        for (int k = 0; k < 4; ++k) { const f32x4 gg = *(const f32x4*)(gn_g + c0 + 4 * k);
#pragma unroll
            for (int j = 0; j < 4; ++j) { const float gv = gt[4 * k + j]; const float sg = gv / (1.f + __builtin_amdgcn_exp2f(-gv * 1.4426950408889634f)); ov[4 * k + j] = sg * v[k][j] * rstd * gg[j]; } }
        u32x4 w0, w1;
        w0.x = cvtpk_s(ov[0], ov[1]); w0.y = cvtpk_s(ov[2], ov[3]); w0.z = cvtpk_s(ov[4], ov[5]); w0.w = cvtpk_s(ov[6], ov[7]);
        w1.x = cvtpk_s(ov[8], ov[9]); w1.y = cvtpk_s(ov[10], ov[11]); w1.z = cvtpk_s(ov[12], ov[13]); w1.w = cvtpk_s(ov[14], ov[15]);
        *(u32x4*)(MIX + trow * DM + c0) = w0; *(u32x4*)(MIX + trow * DM + c0 + 8) = w1;
    }
}
}

namespace attn {
typedef __attribute__((address_space(3))) unsigned char* lptr;
typedef short s16x4 __attribute__((ext_vector_type(4)));
constexpr int KN_OFF = 0, KR_OFF = 16384, V_OFF = 24576, BUF = 40960, SCR_OFF = 2 * BUF, LDS_NEED = SCR_OFF + 8 * 256;
constexpr float THR = 8.f;

__device__ __forceinline__ int v_rd_base(int lane) { return ((lane & 3) << 3) | (((lane >> 2) & 3) << 6) | (((lane >> 4) & 1) << 5) | (((lane >> 5) & 1) << 8); }
constexpr int v_rd_off(int d0, int ks, int half) { return d0 * 512 + ks * 4096 + half * 2048; }
__device__ __forceinline__ unsigned cvtpk(float lo, float hi) { unsigned r; asm volatile("v_cvt_pk_bf16_f32 %0, %1, %2" : "=v"(r) : "v"(lo), "v"(hi)); return r; }
__device__ __forceinline__ s16x4 vtr(lptr p) { return __builtin_bit_cast(s16x4, __builtin_amdgcn_ds_read_tr16_b64_v4i16((__attribute__((address_space(3))) s16x4*)p)); }
__device__ __forceinline__ void dma16(const void* g, lptr l) { __builtin_amdgcn_global_load_lds((const unsigned*)g, (__attribute__((address_space(3))) unsigned*)l, 16, 0, 0); }

struct Src { unsigned kn[2], kr, v[2]; };
__device__ __forceinline__ Src make_src(int wid, int lane) {
    Src s;
#pragma unroll
    for (int i = 0; i < 2; ++i) { const int pi = wid + 8 * i;
        { const int row = 4 * pi + (lane >> 4), colB = ((lane & 15) << 4) ^ ((row & 7) << 4); s.kn[i] = (unsigned)(row * 1024 + colB / 2); }
        { const int sub = 2 * pi + (lane >> 5), kk = (sub >> 2) * 8 + ((lane & 31) >> 2), key = (kk & ~0xC) | ((kk & 4) << 1) | ((kk & 8) >> 1), col = (sub & 3) * 32 + (lane & 3) * 8;
          s.v[i] = (unsigned)(key * 1024 + col); } }
    { const int row = 8 * wid + (lane >> 3), chunk = (lane & 7) ^ ((row >> 1) & 7); s.kr = (unsigned)(row * 64 + chunk * 8); }
    return s;
}

__device__ __forceinline__ void attn_unit(lptr lds, const bf16_t* MQ, const bf16_t* MKN, const bf16_t* KR, const bf16_t* MV, bf16_t* MIX, int b, int h, int qb) {
    const int tid = threadIdx.x, wid = __builtin_amdgcn_readfirstlane(tid >> 6), lane = tid & 63, r32 = lane & 31, hi = lane >> 5;
    const int NT = 4 * qb + 4, cw = 4 * qb + (wid >> 1);
    const size_t tb = (size_t)b * SEQ;
    const Src src = make_src(wid, lane);
    const bf16_t* knb = MKN + tb * 1024 + h * 128; const bf16_t* krb = KR + tb * 64; const bf16_t* vb = MV + tb * 1024 + h * 128;
#define ATT_STAGE(t, buf) do { const size_t ro_ = (size_t)(t) * 64; lptr lb_ = lds + (buf) * BUF + wid * 1024; \
        dma16(knb + ro_ * 1024 + src.kn[0], lb_ + KN_OFF); dma16(knb + ro_ * 1024 + src.kn[1], lb_ + KN_OFF + 8192); \
        dma16(krb + ro_ * 64 + src.kr, lb_ + KR_OFF); \
        dma16(vb + ro_ * 1024 + src.v[0], lb_ + V_OFF); dma16(vb + ro_ * 1024 + src.v[1], lb_ + V_OFF + 8192); } while (0)
    ATT_STAGE(0, 0);
    const size_t qrow = tb + (size_t)qb * 256 + wid * 32 + r32;
    bf16x8 qr[12];
#pragma unroll
    for (int d0 = 0; d0 < 8; ++d0) qr[d0] = *(const bf16x8*)(MQ + qrow * (MH * QKD) + h * NOPE + d0 * 16 + hi * 8);
#pragma unroll
    for (int d0 = 0; d0 < 4; ++d0) qr[8 + d0] = *(const bf16x8*)(MQ + qrow * (MH * QKD) + MH * NOPE + h * ROPE + d0 * 16 + hi * 8);
    float m_reg = -1e30f, l_reg = 0.f;
    f32x16 o[4];
#pragma unroll
    for (int d = 0; d < 4; ++d)
#pragma unroll
        for (int r = 0; r < 16; ++r) o[d][r] = 0.f;
    __attribute__((address_space(3))) float* scr = (__attribute__((address_space(3))) float*)(lds + SCR_OFF + wid * 256);
    int kno[4], kro[4];
#pragma unroll
    for (int dd = 0; dd < 4; ++dd) { kno[dd] = r32 * 256 + (((dd * 16 + hi * 8) * 2) ^ ((r32 & 7) << 4)); kro[dd] = r32 * 128 + 16 * ((2 * dd + hi) ^ ((r32 >> 1) & 7)); }
    const int vro = v_rd_base(lane);
    asm volatile("s_waitcnt vmcnt(0)" ::: "memory"); __builtin_amdgcn_s_barrier(); asm volatile("" ::: "memory");
    for (int t = 0; t < NT; ++t) {
        const int cur = t & 1;
        if (t + 1 < NT) ATT_STAGE(t + 1, cur ^ 1);
        if (t <= cw) {
            lptr kn = lds + cur * BUF + KN_OFF, kr = lds + cur * BUF + KR_OFF, vv = lds + cur * BUF + V_OFF + vro;
            f32x16 p0, p1;
#pragma unroll
            for (int r = 0; r < 16; ++r) { p0[r] = 0.f; p1[r] = 0.f; }
#pragma unroll
            for (int d0 = 0; d0 < 8; ++d0) { lptr a = kn + kno[d0 & 3] + (d0 >> 2) * 128;
                const bf16x8 b0 = *(const __attribute__((address_space(3))) bf16x8*)a, b1 = *(const __attribute__((address_space(3))) bf16x8*)(a + 32 * 256);
                p0 = __builtin_amdgcn_mfma_f32_32x32x16_bf16(b0, qr[d0], p0, 0, 0, 0); p1 = __builtin_amdgcn_mfma_f32_32x32x16_bf16(b1, qr[d0], p1, 0, 0, 0); }
#pragma unroll
            for (int d0 = 0; d0 < 4; ++d0) { lptr a = kr + kro[d0];
                const bf16x8 b0 = *(const __attribute__((address_space(3))) bf16x8*)a, b1 = *(const __attribute__((address_space(3))) bf16x8*)(a + 32 * 128);
                p0 = __builtin_amdgcn_mfma_f32_32x32x16_bf16(b0, qr[8 + d0], p0, 0, 0, 0); p1 = __builtin_amdgcn_mfma_f32_32x32x16_bf16(b1, qr[8 + d0], p1, 0, 0, 0); }
            float pmax = p0[0];
#pragma unroll
            for (int r = 1; r < 16; ++r) pmax = fmaxf(pmax, p0[r]);
#pragma unroll
            for (int r = 0; r < 16; ++r) pmax = fmaxf(pmax, p1[r]);
            { auto rr = __builtin_amdgcn_permlane32_swap(__float_as_uint(pmax), __float_as_uint(pmax), false, false); pmax = fmaxf(__uint_as_float(rr[0]), __uint_as_float(rr[1])); }
            float mn, alpha;
            if (__all(pmax - m_reg <= THR)) { mn = m_reg; alpha = 1.f; }
            else { mn = fmaxf(m_reg, pmax); alpha = __builtin_amdgcn_exp2f(m_reg - mn); m_reg = mn; }
#pragma unroll
            for (int r = 0; r < 16; ++r) { p0[r] = __builtin_amdgcn_exp2f(p0[r] - mn); p1[r] = __builtin_amdgcn_exp2f(p1[r] - mn); }
            float ps = 0.f;
#pragma unroll
            for (int r = 0; r < 16; ++r) ps += p0[r] + p1[r];
            { auto rr = __builtin_amdgcn_permlane32_swap(__float_as_uint(ps), __float_as_uint(ps), false, false); ps = __uint_as_float(rr[0]) + __uint_as_float(rr[1]); }
            l_reg = l_reg * alpha + ps;
            bf16x8 pa0, pa1, pa2, pa3;
#define ATT_PK4(P, B_, OUT) do { unsigned a0 = cvtpk(P[B_ + 0], P[B_ + 1]), a1 = cvtpk(P[B_ + 2], P[B_ + 3]); unsigned b0 = cvtpk(P[B_ + 4], P[B_ + 5]), b1 = cvtpk(P[B_ + 6], P[B_ + 7]); \
        auto r0 = __builtin_amdgcn_permlane32_swap(a0, b0, false, false); auto r1 = __builtin_amdgcn_permlane32_swap(a1, b1, false, false); \
        u32x4 w = {r0[0], r1[0], r0[1], r1[1]}; OUT = __builtin_bit_cast(bf16x8, w); } while (0)
            ATT_PK4(p0, 0, pa0); ATT_PK4(p0, 8, pa1); ATT_PK4(p1, 0, pa2); ATT_PK4(p1, 8, pa3);
#undef ATT_PK4
            if (__any(alpha < 1.f)) { if (hi == 0) scr[r32] = alpha; asm volatile("s_waitcnt lgkmcnt(0)" ::: "memory");
#pragma unroll
                for (int r = 0; r < 16; ++r) { const float a = scr[crow(r, hi)];
#pragma unroll
                    for (int d = 0; d < 4; ++d) o[d][r] *= a; } }
#pragma unroll
            for (int d0 = 0; d0 < 4; ++d0) {
                s16x4 lo[4], hh[4];
#pragma unroll
                for (int ks = 0; ks < 4; ++ks) { lo[ks] = vtr(vv + v_rd_off(d0, ks, 0)); hh[ks] = vtr(vv + v_rd_off(d0, ks, 1)); }
#define ATT_VF(k) (bf16x8){lo[k][0], lo[k][1], lo[k][2], lo[k][3], hh[k][0], hh[k][1], hh[k][2], hh[k][3]}
                o[d0] = __builtin_amdgcn_mfma_f32_32x32x16_bf16(pa0, ATT_VF(0), o[d0], 0, 0, 0);
                o[d0] = __builtin_amdgcn_mfma_f32_32x32x16_bf16(pa1, ATT_VF(1), o[d0], 0, 0, 0);
                o[d0] = __builtin_amdgcn_mfma_f32_32x32x16_bf16(pa2, ATT_VF(2), o[d0], 0, 0, 0);
                o[d0] = __builtin_amdgcn_mfma_f32_32x32x16_bf16(pa3, ATT_VF(3), o[d0], 0, 0, 0);
#undef ATT_VF
            }
        }
        asm volatile("s_waitcnt vmcnt(0) lgkmcnt(0)" ::: "memory"); __builtin_amdgcn_s_barrier(); asm volatile("" ::: "memory");
    }
#undef ATT_STAGE
    if (hi == 0) scr[32 + r32] = l_reg;
    asm volatile("s_waitcnt lgkmcnt(0)" ::: "memory");
    bf16_t* Ow = MIX + (tb + (size_t)qb * 256 + wid * 32) * DM + 1024 + h * 128;
#pragma unroll
    for (int r = 0; r < 16; ++r) { const int orow = crow(r, hi); const float rl = __builtin_amdgcn_rcpf(scr[32 + orow]);
#pragma unroll
        for (int d0 = 0; d0 < 4; ++d0) { const float v = o[d0][r] * rl; const float vn = __shfl_xor(v, 1);
            if ((r32 & 1) == 0) *(unsigned*)(Ow + (size_t)orow * DM + d0 * 32 + r32) = cvtpk(v, vn); } }
    asm volatile("s_waitcnt lgkmcnt(0)" ::: "memory");
}

__device__ __forceinline__ void attn_phase(lptr lds, const bf16_t* MQ, const bf16_t* MKN, const bf16_t* KR, const bf16_t* MV, bf16_t* MIX) {
    const int G = gridDim.x, bx = blockIdx.x, vcu = (G % 8 == 0) ? (bx % 8) * (G / 8) + bx / 8 : bx;
    for (int u = vcu; u < NB * MH * 8; u += G) {
        const int bh = u >> 3, s = u & 7;
        attn_unit(lds, MQ, MKN, KR, MV, MIX, bh / MH, bh % MH, 15 - s);
        attn_unit(lds, MQ, MKN, KR, MV, MIX, bh / MH, bh % MH, s);
    }
}
}

__device__ __forceinline__ void phase_ln(float* y, const float* g, const float* bta, bf16_t* yb) {
    const int lane = threadIdx.x & 63, gw = blockIdx.x * 8 + (threadIdx.x >> 6), ngw = gridDim.x * 8;
    for (int row = gw; row < T; row += ngw) {
        f32x4* yr = (f32x4*)(y + (size_t)row * DM) + lane;
        f32x4 v[8]; float s = 0.f;
#pragma unroll
        for (int j = 0; j < 8; ++j) { v[j] = yr[64 * j]; s += (v[j].x + v[j].y) + (v[j].z + v[j].w); }
        const float mean = wave_sum(s) * (1.f / DM); float s2 = 0.f;
#pragma unroll
        for (int j = 0; j < 8; ++j) { v[j] = v[j] - mean; s2 += (v[j].x * v[j].x + v[j].y * v[j].y) + (v[j].z * v[j].z + v[j].w * v[j].w); }
        const float rstd = 1.0f / sqrtf(wave_sum(s2) * (1.f / DM) + EPS);
#pragma unroll
        for (int j = 0; j < 8; ++j) { const int c = 4 * lane + 256 * j; const f32x4 gg = *(const f32x4*)(g + c), bb = *(const f32x4*)(bta + c);
            const f32x4 o = v[j] * rstd * gg + bb; yr[64 * j] = o;
            if (yb) { u32x2 w; w.x = pk2(o.x, o.y); w.y = pk2(o.z, o.w); *(u32x2*)(yb + (size_t)row * DM + c) = w; } }
    }
}


#define LAS __attribute__((address_space(3)))
#define XB_TMO      128
#define XB_XCNT(j)  (256  + 64 * (j))
#define XB_XSUB(j)  (1280 + 64 * (j))
#define XB_XGEN(j)  (2304 + 64 * (j))
#define XB_TOP      3328
#define XB_TOPGEN   3392
#define XCD_BAR_WORDS 3456
#define XB_SPIN_CAP (1u << 22)
__device__ __forceinline__ unsigned xb_ld(unsigned* p)              { return __hip_atomic_load(p, __ATOMIC_RELAXED, __HIP_MEMORY_SCOPE_AGENT); }
__device__ __forceinline__ unsigned xb_add(unsigned* p, unsigned v) { return __hip_atomic_fetch_add(p, v, __ATOMIC_RELAXED, __HIP_MEMORY_SCOPE_AGENT); }
__device__ __forceinline__ unsigned xb_xcc_id() { return (unsigned)__builtin_amdgcn_s_getreg((3 << 11) | 20) & 0xFu; }
#define XB_SPIN(cond, bar) do { unsigned _sp = 0; while (cond) { __builtin_amdgcn_s_sleep(1); \
    if ((++_sp & 255u) == 0u) { if (xb_ld(&(bar)[XB_TMO])) break; if (_sp > XB_SPIN_CAP) { atomicAdd(&(bar)[XB_TMO], 1u); break; } } } } while (0)
struct XcdBarrier { unsigned* bar; unsigned x; volatile LAS unsigned* st; };
__device__ __forceinline__ XcdBarrier xcd_barrier_post(unsigned* bar, volatile LAS unsigned* st) {
    XcdBarrier b; b.bar = bar; b.x = xb_xcc_id(); b.st = st;
    if (threadIdx.x == 0) (void)xb_add(&bar[XB_XCNT(b.x)], 1u);
    return b;
}
__device__ __forceinline__ void xcd_barrier_complete(unsigned* bar, unsigned x, unsigned& nloc, unsigned& nx) {
    const unsigned G = gridDim.x * gridDim.y * gridDim.z;
    unsigned sum, cnt, mine, sp = 0u;
    for (;;) {
        sum = 0u; cnt = 0u; mine = 0u;
#pragma unroll
        for (unsigned j = 0; j < 16; ++j) { const unsigned c = xb_ld(&bar[XB_XCNT(j)]); sum += c; cnt += (c > 0u) ? 1u : 0u; mine = (j == x) ? c : mine; }
        if (sum == G) break;
        __builtin_amdgcn_s_sleep(1);
        if ((++sp & 255u) == 0u) { if (xb_ld(&bar[XB_TMO])) break; if (sp > XB_SPIN_CAP) { atomicAdd(&bar[XB_TMO], 1u); break; } }
    }
    nloc = mine > 0u ? mine : 1u; nx = cnt > 0u ? cnt : 1u;
}
__device__ __forceinline__ void xcd_barrier(const XcdBarrier& b) {
    asm volatile("s_waitcnt vmcnt(0)" ::: "memory");
    __syncthreads();
    if (threadIdx.x == 0) {
        unsigned* bar = b.bar;
        __builtin_amdgcn_s_waitcnt(0);
        unsigned nloc = b.st[0], nx = b.st[1];
        if (nloc == 0u) { xcd_barrier_complete(bar, b.x, nloc, nx); b.st[0] = nloc; b.st[1] = nx; }
        const unsigned old = xb_add(&bar[XB_XSUB(b.x)], 1u);
        const unsigned gen = old / nloc;
        if (old + 1u == (gen + 1u) * nloc) {
            __builtin_amdgcn_fence(__ATOMIC_RELEASE, "agent");
            asm volatile("s_waitcnt vmcnt(0)" ::: "memory");
            const unsigned og = xb_add(&bar[XB_TOP], 1u);
            const unsigned tg = og / nx;
            if (og + 1u == (tg + 1u) * nx) xb_add(&bar[XB_TOPGEN], 1u);
            else XB_SPIN(xb_ld(&bar[XB_TOPGEN]) == tg, bar);
            __builtin_amdgcn_fence(__ATOMIC_ACQUIRE, "agent");
            xb_add(&bar[XB_XGEN(b.x)], 1u);
            asm volatile("s_waitcnt vmcnt(0)" ::: "memory");
        } else {
            XB_SPIN(xb_ld(&bar[XB_XGEN(b.x)]) == gen, bar);
            __builtin_amdgcn_fence(__ATOMIC_ACQUIRE, "agent");
            asm volatile("s_waitcnt vmcnt(0)" ::: "memory");
        }
    }
    __syncthreads();
}
constexpr int LDS_MISC_OFF = 147456 - 256;
constexpr size_t WS_BAR = 65536;

__global__ void __launch_bounds__(NTHREADS, 2) mk_fwd(Params p) {
    extern __shared__ __attribute__((aligned(16))) unsigned char lds[];
    unsigned char* ws = p.ws;
    volatile LAS unsigned* misc = (volatile LAS unsigned*)((LAS unsigned char*)lds + LDS_MISC_OFF);
    if (threadIdx.x < 64) misc[threadIdx.x] = 0u;
    __syncthreads();
    const XcdBarrier bar = xcd_barrier_post((unsigned*)(ws + WS_BAR), misc);
#define IN(k) (p.ph_lo <= (k) && (k) < p.ph_hi)
#define SEAM(k) do { if (IN(k) && IN((k) + 1)) xcd_barrier(bar); } while (0)
    if (IN(0)) phase_prep(p, lds);
    SEAM(0);
    if (IN(1)) { pg8::Gemm g{(const bf16_t*)(ws + WS_XB), (const bf16_t*)(ws + WS_WIN), T, INWP, DM}; pg8::StaticOrder S; S.init(T, INWP, gridDim.x, blockIdx.x);
        pg8::EpiProj e{ws};
        pg8::gemm_phase<pg8::EpiProj, pg8::StaticOrder, true, true>((PG8_LAS unsigned char*)lds, g, S, e); }
    SEAM(1);
    if (IN(3)) {
        for (int it = blockIdx.x; it < NB * RH * 2; it += gridDim.x) ret::scan_item((ret::lptr)lds, (const bf16_t*)(ws + WS_RK), (const bf16_t*)(ws + WS_RV), (bf16_t*)(ws + WS_SP), it >> 1, it & 1);
        __syncthreads();
        { pg8::Gemm g{(const bf16_t*)(ws + WS_CQ), (const bf16_t*)(ws + WS_WUQ), T, MH * QKD, QR}; pg8::StaticOrder S; S.init(T, MH * QKD, gridDim.x, gridDim.x - 1 - blockIdx.x);
          pg8::EpiQ e{(bf16_t*)(ws + WS_MQ), (const float*)(ws + WS_SSQ), (const float*)(ws + WS_R64)};
          pg8::gemm_phase<pg8::EpiQ, pg8::StaticOrder, true, true>((PG8_LAS unsigned char*)lds, g, S, e); }
        { pg8::Gemm g{(const bf16_t*)(ws + WS_CKV), (const bf16_t*)(ws + WS_WUKV), T, 2048, KVR}; pg8::StaticOrder S; S.init(T, 2048, gridDim.x, blockIdx.x);
          pg8::EpiKV e{ws, (const float*)(ws + WS_SSQ)};
          pg8::gemm_phase<pg8::EpiKV, pg8::StaticOrder, true, true>((PG8_LAS unsigned char*)lds, g, S, e); }
        __syncthreads();
    }
    SEAM(3);
    if (IN(4)) {
        attn::attn_phase((attn::lptr)lds, (const bf16_t*)(ws + WS_MQ), (const bf16_t*)(ws + WS_MKN), (const bf16_t*)(ws + WS_KR), (const bf16_t*)(ws + WS_MV), (bf16_t*)(ws + WS_MIX)); }
    SEAM(4);
    if (IN(5)) { for (int it = blockIdx.x; it < NB * RH * NCH; it += gridDim.x)
            ret::out_item((ret::lptr)lds, (const bf16_t*)(ws + WS_RQ), (const bf16_t*)(ws + WS_RK), (const bf16_t*)(ws + WS_RV), (const bf16_t*)(ws + WS_RG), (const bf16_t*)(ws + WS_SP), p.ret_gn_g, (bf16_t*)(ws + WS_MIX), it); }
    SEAM(5);
    if (IN(6)) { pg8::Gemm g{(const bf16_t*)(ws + WS_MIX), (const bf16_t*)(ws + WS_WOUT), T, DM, DM}; pg8::StaticOrder S; S.init(T, DM, gridDim.x, blockIdx.x);
        pg8::EpiResF32 e{p.x, p.out};
        pg8::gemm_phase<pg8::EpiResF32, pg8::StaticOrder, true, true>((PG8_LAS unsigned char*)lds, g, S, e); }
    SEAM(6);
    if (IN(7)) phase_ln(p.out, p.ln1_g, p.ln1_b, (bf16_t*)(ws + WS_X1B));
    SEAM(7);
    if (IN(8)) { pg8::Gemm g{(const bf16_t*)(ws + WS_X1B), (const bf16_t*)(ws + WS_WUP), T, DFF, DM}; pg8::StaticOrder S; S.init(T, DFF, gridDim.x, blockIdx.x);
        pg8::EpiRelu2 e{(bf16_t*)(ws + WS_HDN)};
        pg8::gemm_phase<pg8::EpiRelu2, pg8::StaticOrder, true, true>((PG8_LAS unsigned char*)lds, g, S, e); }
    SEAM(8);
    if (IN(9)) { pg8::Gemm g{(const bf16_t*)(ws + WS_HDN), (const bf16_t*)(ws + WS_WDN), T, DM, DFF}; pg8::StaticOrder S; S.init(T, DM, gridDim.x, blockIdx.x);
        pg8::EpiResF32 e{p.out, p.out};
        pg8::gemm_phase<pg8::EpiResF32, pg8::StaticOrder, true, true>((PG8_LAS unsigned char*)lds, g, S, e); }
    SEAM(9);
    if (IN(10)) phase_ln(p.out, p.ln2_g, p.ln2_b, nullptr);
#undef IN
#undef SEAM
}

extern "C" void kernel_launch(void* const* d_in, const int* in_sizes, int n_in, void* d_out, int out_size, void* d_ws, size_t ws_size, hipStream_t stream) {
    static int grid = 0;
    if (grid == 0) {
        if (n_in != 16 || in_sizes[0] != T * DM || out_size != T * DM || ws_size < WS_END) {
            fprintf(stderr, "kernel_launch: unexpected shapes n_in %d in0 %d out %d ws %zu\n", n_in, n_in > 0 ? in_sizes[0] : -1, out_size, ws_size); grid = -1; return; }
        int dev = 0, cus = 0, per_cu = 0;
        hipGetDevice(&dev); hipDeviceGetAttribute(&cus, hipDeviceAttributeMultiprocessorCount, dev);
        hipFuncSetAttribute((const void*)mk_fwd, hipFuncAttributeMaxDynamicSharedMemorySize, LDS_BYTES);
        hipOccupancyMaxActiveBlocksPerMultiprocessor(&per_cu, (const void*)mk_fwd, NTHREADS, LDS_BYTES);
        if (per_cu < 1) { fprintf(stderr, "kernel_launch: occupancy query says %d blocks per CU\n", per_cu); per_cu = 1; }
        (void)hipGetLastError();
        grid = cus * per_cu;
    }
    if (grid < 0) return;
    Params p{};
    p.x = (const float*)d_in[0]; p.pos = (const int*)d_in[1]; p.w_in = (const float*)d_in[2]; p.q_norm_g = (const float*)d_in[3];
    p.w_uq = (const float*)d_in[4]; p.kv_norm_g = (const float*)d_in[5]; p.w_uk = (const float*)d_in[6]; p.w_uv = (const float*)d_in[7];
    p.ret_gn_g = (const float*)d_in[8]; p.w_out = (const float*)d_in[9]; p.ln1_g = (const float*)d_in[10]; p.ln1_b = (const float*)d_in[11];
    p.w_up = (const float*)d_in[12]; p.w_down = (const float*)d_in[13]; p.ln2_g = (const float*)d_in[14]; p.ln2_b = (const float*)d_in[15];
    p.out = (float*)d_out; p.ws = (unsigned char*)d_ws; p.ph_lo = 0; p.ph_hi = 11;
    if (hipMemsetAsync((char*)d_ws, 0, 1 * MiB, stream) != hipSuccess) { fprintf(stderr, "kernel_launch: memset of the control words failed\n"); return; }
    void* args[] = {&p};
    hipError_t e = hipLaunchCooperativeKernel((const void*)mk_fwd, dim3(grid), dim3(NTHREADS), args, LDS_BYTES, stream);
    if (e != hipSuccess) fprintf(stderr, "cooperative launch failed: %s (grid %d)\n", hipGetErrorString(e), grid);
}
```
